# Optimizing an MI355X kernel written in HIP

```python
import jax, jax.numpy as jnp
from jax import lax
import numpy as np

D_MODEL = 1024
BATCH = 4
SEQ = 4096
DEPTH = 1

CHUNK = 64
MIX_WIDTH = D_MODEL
HG_HEADS = 4
HG_WIDTH = MIX_WIDTH // 2
HG_HEAD_DIM = HG_WIDTH // HG_HEADS
POOL_WINDOWS = (2, 4, 8, 16)
POOL_GROUPS = 4
POOL_WIDTH = MIX_WIDTH - HG_WIDTH
POOL_GDIM = POOL_WIDTH // POOL_GROUPS
IN_WIDTH = 4 * HG_WIDTH + POOL_WIDTH
N_BRANCH = 2
MOE_GROUPS = 4
MOE_EXPERTS_PER_GROUP = 8
N_EXPERTS = MOE_GROUPS * MOE_EXPERTS_PER_GROUP
MOE_TOP_K = 2
EXPERT_FF = D_MODEL // 2
MOE_BLOCK = 256
EPS = 1e-6
ADA_INIT = 0.5

kernel_name = "hybrid_hgrn2_pool_hmoe_block"


def rms_norm(x, g):
    xf = x.astype(jnp.float32)
    y = xf * lax.rsqrt(jnp.mean(xf * xf, axis=-1, keepdims=True) + EPS)
    return (y * g.astype(jnp.float32)).astype(x.dtype)


def hgrn2_mixer(q_raw, f_raw, v_raw, g_raw, lb, norm_g):
    f32 = jnp.float32
    Bsz, S, _ = q_raw.shape
    nC = S // CHUNK
    heads = lambda t: t.astype(f32).reshape(Bsz, S, HG_HEADS, HG_HEAD_DIM)
    q = jax.nn.silu(heads(q_raw))
    lbh = lb.astype(f32).reshape(HG_HEADS, HG_HEAD_DIM)
    f = lbh + (1.0 - lbh) * jax.nn.sigmoid(heads(f_raw))
    k = 1.0 - f
    log_f = jnp.log(f)

    def chunks(t):
        return t.reshape(Bsz, nC, CHUNK, HG_HEADS, HG_HEAD_DIM).transpose(1, 0, 3, 2, 4)

    qc, kc, vc = chunks(q), chunks(k), chunks(heads(v_raw))
    bc = jnp.cumsum(chunks(log_f), axis=3)
    causal = jnp.tril(jnp.ones((CHUNK, CHUNK), bool))[:, :, None]

    def step(state, inp):
        qb, kb, vb, bb = inp
        diff = bb[:, :, :, None, :] - bb[:, :, None, :, :]
        decay = jnp.exp(jnp.where(causal, diff, -jnp.inf))
        scores = jnp.sum(qb[:, :, :, None, :] * kb[:, :, None, :, :] * decay, axis=-1)
        o = (jnp.einsum('bhts,bhsv->bhtv', scores, vb)
             + jnp.einsum('bhtk,bhkv->bhtv', qb * jnp.exp(bb), state))
        b_last = bb[:, :, -1:, :]
        state = (jnp.exp(b_last[:, :, 0, :, None]) * state
                 + jnp.einsum('bhsk,bhsv->bhkv', kb * jnp.exp(b_last - bb), vb))
        return state, o

    s0 = jnp.zeros((Bsz, HG_HEADS, HG_HEAD_DIM, HG_HEAD_DIM), f32)
    _, o = lax.scan(step, s0, (qc, kc, vc, bc))
    o = o.transpose(1, 0, 3, 2, 4).reshape(Bsz, S, HG_HEADS, HG_HEAD_DIM)
    o = o * lax.rsqrt(jnp.mean(o * o, axis=-1, keepdims=True) + EPS)
    o = o.reshape(Bsz, S, HG_WIDTH) * norm_g.astype(f32) * jax.nn.silu(g_raw.astype(f32))
    return o.astype(q_raw.dtype)


def multiscale_pool(u, w_grp, ls):
    f32 = jnp.float32
    Bsz, S, _ = u.shape
    uf = u.astype(f32).reshape(Bsz, S, POOL_GROUPS, POOL_GDIM)
    cs = jnp.pad(jnp.cumsum(uf, axis=1), ((0, 0), (1, 0), (0, 0), (0, 0)))
    win = jnp.array(POOL_WINDOWS, jnp.int32)
    t = jnp.arange(S, dtype=jnp.int32)[:, None]
    lo = jnp.maximum(t + 1 - win[None, :], 0)
    grp = jnp.arange(POOL_GROUPS, dtype=jnp.int32)[None, :]
    window_sum = cs[:, 1:] - cs[:, lo, grp]
    count = jnp.minimum(t + 1, win[None, :]).astype(f32)
    pooled = window_sum / count[None, :, :, None] - uf
    mixed = jnp.einsum('bsgc,gcd->bsgd', pooled, w_grp.astype(f32)).reshape(Bsz, S, POOL_WIDTH)
    return (mixed * ls.astype(f32)).astype(u.dtype)


def hierarchical_moe(h, w_rg, b_rg, w_re, b_re, w_gate_e, w_up_e, w_down_e):
    f32 = jnp.float32
    Bsz, S, D = h.shape
    N = Bsz * S
    hf = h.reshape(N, D)
    p_g = jax.nn.softmax((hf @ w_rg + b_rg).astype(f32), axis=-1)
    p_top_g, g_idx = lax.top_k(p_g, 1)
    e_logits = (hf @ w_re + b_re).astype(f32).reshape(N, MOE_GROUPS, MOE_EXPERTS_PER_GROUP)
    e_sel = jnp.take_along_axis(e_logits, g_idx[:, :, None], axis=1)[:, 0]
    p_top_e, e_local = lax.top_k(jax.nn.softmax(e_sel, axis=-1), MOE_TOP_K)
    weights = p_top_g * p_top_e / jnp.sum(p_top_e, axis=-1, keepdims=True)
    e_global = g_idx * MOE_EXPERTS_PER_GROUP + e_local

    A = N * MOE_TOP_K
    e_flat = e_global.reshape(A).astype(jnp.int32)
    tok_flat = jnp.repeat(jnp.arange(N, dtype=jnp.int32), MOE_TOP_K)
    w_flat = weights.reshape(A)
    order = jnp.argsort(e_flat)
    e_sorted = e_flat[order]
    counts = jnp.bincount(e_flat, length=N_EXPERTS)
    pcounts = ((counts + MOE_BLOCK - 1) // MOE_BLOCK) * MOE_BLOCK
    start = jnp.cumsum(counts) - counts
    pend = jnp.cumsum(pcounts)
    pstart = pend - pcounts
    dest = pstart[e_sorted] + jnp.arange(A, dtype=jnp.int32) - start[e_sorted]
    n_blocks = -(-A // MOE_BLOCK) + N_EXPERTS
    P = n_blocks * MOE_BLOCK
    row_tok = jnp.full((P,), N, jnp.int32).at[dest].set(tok_flat[order])
    row_w = jnp.zeros((P,), f32).at[dest].set(w_flat[order])
    block_e = jnp.minimum(jnp.searchsorted(pend, jnp.arange(n_blocks) * MOE_BLOCK, side='right'),
                          N_EXPERTS - 1).astype(jnp.int32)
    x_pad = jnp.concatenate([hf, jnp.zeros((1, D), hf.dtype)], axis=0)
    xb = x_pad[row_tok].reshape(n_blocks, MOE_BLOCK, D)

    def expert_block(args):
        xblk, e = args
        return (jax.nn.silu(xblk @ w_gate_e[e]) * (xblk @ w_up_e[e])) @ w_down_e[e]

    yb = lax.map(expert_block, (xb, block_e))
    y = jax.ops.segment_sum(yb.reshape(P, D).astype(f32) * row_w[:, None], row_tok,
                            num_segments=N + 1)[:N]
    return y.reshape(Bsz, S, D).astype(h.dtype)


def setup_inputs(seed: int = 0) -> dict:
    key = jax.random.key(seed)
    ks = jax.random.split(key, 26)
    f32 = jnp.float32
    D = D_MODEL

    def nrm(k, shape, scale):
        return scale * jax.random.normal(k, shape, f32)

    return {
        "x": nrm(ks[0], (BATCH, SEQ, D), 1.0),
        "c": nrm(ks[1], (BATCH, D), 1.0),
        "w_ada": nrm(ks[2], (DEPTH, D, 6 * D), ADA_INIT * D ** -0.5),
        "b_ada": nrm(ks[3], (DEPTH, 6 * D), 0.02),
        "g_pre_mix": 1.0 + nrm(ks[4], (DEPTH, D), 0.02),
        "g_post_mix": 1.0 + nrm(ks[5], (DEPTH, D), 0.02),
        "w_in": nrm(ks[6], (DEPTH, D, IN_WIDTH), D ** -0.5),
        "hg_lb_logits": nrm(ks[7], (DEPTH + 1, HG_WIDTH), 0.1),
        "hg_norm_g": 1.0 + nrm(ks[8], (DEPTH, HG_WIDTH), 0.02),
        "pool_w": nrm(ks[9], (DEPTH, POOL_GROUPS, POOL_GDIM, POOL_GDIM), POOL_GDIM ** -0.5),
        "pool_scale": 1.0 + nrm(ks[10], (DEPTH, POOL_WIDTH), 0.02),
        "w_branch_hg": nrm(ks[11], (DEPTH, HG_WIDTH, D), HG_WIDTH ** -0.5),
        "w_branch_pool": nrm(ks[12], (DEPTH, POOL_WIDTH, D), POOL_WIDTH ** -0.5),
        "w_gate": nrm(ks[13], (DEPTH, D, N_BRANCH * D), D ** -0.5),
        "b_gate": nrm(ks[14], (DEPTH, N_BRANCH * D), 0.02),
        "w_out": nrm(ks[15], (DEPTH, D, D), D ** -0.5),
        "g_pre_ffn": 1.0 + nrm(ks[16], (DEPTH, D), 0.02),
        "g_post_ffn": 1.0 + nrm(ks[17], (DEPTH, D), 0.02),
        "w_router_group": nrm(ks[18], (DEPTH, D, MOE_GROUPS), D ** -0.5),
        "b_router_group": nrm(ks[19], (DEPTH, MOE_GROUPS), 0.01),
        "w_router_expert": nrm(ks[20], (DEPTH, D, N_EXPERTS), D ** -0.5),
        "b_router_expert": nrm(ks[21], (DEPTH, N_EXPERTS), 0.01),
        "w_exp_gate": nrm(ks[22], (DEPTH, N_EXPERTS, D, EXPERT_FF), D ** -0.5),
        "w_exp_up": nrm(ks[23], (DEPTH, N_EXPERTS, D, EXPERT_FF), D ** -0.5),
        "w_exp_down": nrm(ks[24], (DEPTH, N_EXPERTS, EXPERT_FF, D), EXPERT_FF ** -0.5),
    }


def reference(x, c, w_ada, b_ada, g_pre_mix, g_post_mix, w_in, hg_lb_logits, hg_norm_g, pool_w,
              pool_scale, w_branch_hg, w_branch_pool, w_gate, b_gate, w_out, g_pre_ffn, g_post_ffn,
              w_router_group, b_router_group, w_router_expert, b_router_expert, w_exp_gate,
              w_exp_up, w_exp_down):
    lb_all = jnp.cumsum(jax.nn.softmax(hg_lb_logits.astype(jnp.float32), axis=0), axis=0)
    cond = jax.nn.silu(c)
    h = x
    for l in range(DEPTH):
        ada = (cond @ w_ada[l] + b_ada[l])[:, None, :]
        sh1, sc1, gt1, sh2, sc2, gt2 = jnp.split(ada, 6, axis=-1)

        hn = rms_norm(h, g_pre_mix[l]) * (1.0 + sc1) + sh1
        proj = hn @ w_in[l]
        q, f, i, g, u = jnp.split(proj, [HG_WIDTH, 2 * HG_WIDTH, 3 * HG_WIDTH, 4 * HG_WIDTH], axis=-1)
        y_hg = hgrn2_mixer(q, f, i, g, lb_all[l], hg_norm_g[l]) @ w_branch_hg[l]
        y_pool = multiscale_pool(u, pool_w[l], pool_scale[l]) @ w_branch_pool[l]
        gate_hg, gate_pool = jnp.split(jax.nn.sigmoid(hn @ w_gate[l] + b_gate[l]), 2, axis=-1)
        mix = (gate_hg * y_hg + gate_pool * y_pool) @ w_out[l]
        h = h + gt1 * rms_norm(mix, g_post_mix[l])

        hn = rms_norm(h, g_pre_ffn[l]) * (1.0 + sc2) + sh2
        y = hierarchical_moe(hn, w_router_group[l], b_router_group[l], w_router_expert[l],
                             b_router_expert[l], w_exp_gate[l], w_exp_up[l], w_exp_down[l])
        h = h + gt2 * rms_norm(y, g_post_ffn[l])
    return h
```

```cpp
#include <hip/hip_runtime.h>
#include <cstdio>
#include <cstdint>

#define LAS __attribute__((address_space(3)))
#define GAS __attribute__((address_space(1)))
#define DI __device__ __forceinline__

#define XB_TMO      128
#define XB_XCNT(j)  (256  + 64 * (j))
#define XB_XSUB(j)  (1280 + 64 * (j))
#define XB_XGEN(j)  (2304 + 64 * (j))
#define XB_TOP      3328
#define XB_TOPGEN   3392
#define XCD_BAR_WORDS 3456
#define XB_SPIN_CAP (1u << 18)

DI unsigned xb_ld(unsigned* p)              { return __hip_atomic_load(p, __ATOMIC_RELAXED, __HIP_MEMORY_SCOPE_AGENT); }
DI unsigned xb_add(unsigned* p, unsigned v) { return __hip_atomic_fetch_add(p, v, __ATOMIC_RELAXED, __HIP_MEMORY_SCOPE_AGENT); }
DI unsigned xb_xcc_id() { return (unsigned)__builtin_amdgcn_s_getreg((3 << 11) | 20) & 0xFu; }
#define XB_SPIN(cond, bar) do { unsigned _sp = 0; while (cond) { __builtin_amdgcn_s_sleep(1); \
    if ((++_sp & 255u) == 0u) { if (xb_ld(&(bar)[XB_TMO])) break; if (_sp > XB_SPIN_CAP) { atomicAdd(&(bar)[XB_TMO], 1u); break; } } } } while (0)

struct XcdBarrier { unsigned* bar; unsigned x; volatile LAS unsigned* st; };

DI XcdBarrier xcd_barrier_post(unsigned* bar, volatile LAS unsigned* st) {
    XcdBarrier b; b.bar = bar; b.x = xb_xcc_id(); b.st = st;
    if (threadIdx.x == 0) (void)xb_add(&bar[XB_XCNT(b.x)], 1u);
    return b;
}
DI void xcd_barrier_complete(unsigned* bar, unsigned x, unsigned& nloc, unsigned& nx) {
    const unsigned G = gridDim.x * gridDim.y * gridDim.z;
    unsigned sum, cnt, mine, sp = 0u;
    for (;;) {
        sum = 0u; cnt = 0u; mine = 0u;
#pragma unroll
        for (unsigned j = 0; j < 16; ++j) { const unsigned c = xb_ld(&bar[XB_XCNT(j)]); sum += c; cnt += (c > 0u) ? 1u : 0u; mine = (j == x) ? c : mine; }
        if (sum == G) break;
        __builtin_amdgcn_s_sleep(1);
        if ((++sp & 255u) == 0u) { if (xb_ld(&bar[XB_TMO])) break; if (sp > XB_SPIN_CAP) { atomicAdd(&bar[XB_TMO], 1u); break; } }
    }
    nloc = mine > 0u ? mine : 1u; nx = cnt > 0u ? cnt : 1u;
}
DI void xcd_barrier(const XcdBarrier& b) {
    asm volatile("s_waitcnt vmcnt(0)" ::: "memory");
    __syncthreads();
    if (threadIdx.x == 0) {
        unsigned* bar = b.bar;
        __builtin_amdgcn_s_waitcnt(0);
        unsigned nloc = b.st[0], nx = b.st[1];
        if (nloc == 0u) { xcd_barrier_complete(bar, b.x, nloc, nx); b.st[0] = nloc; b.st[1] = nx; }
        const unsigned old = xb_add(&bar[XB_XSUB(b.x)], 1u);
        const unsigned gen = old / nloc;
        if (old + 1u == (gen + 1u) * nloc) {
            __builtin_amdgcn_fence(__ATOMIC_RELEASE, "agent");
            asm volatile("s_waitcnt vmcnt(0)" ::: "memory");
            const unsigned og = xb_add(&bar[XB_TOP], 1u);
            const unsigned tg = og / nx;
            if (og + 1u == (tg + 1u) * nx) xb_add(&bar[XB_TOPGEN], 1u);
            else XB_SPIN(xb_ld(&bar[XB_TOPGEN]) == tg, bar);
            __builtin_amdgcn_fence(__ATOMIC_ACQUIRE, "agent");
            xb_add(&bar[XB_XGEN(b.x)], 1u);
            asm volatile("s_waitcnt vmcnt(0)" ::: "memory");
        } else {
            XB_SPIN(xb_ld(&bar[XB_XGEN(b.x)]) == gen, bar);
            __builtin_amdgcn_fence(__ATOMIC_ACQUIRE, "agent");
            asm volatile("s_waitcnt vmcnt(0)" ::: "memory");
        }
    }
    __syncthreads();
}


#ifndef REP_P0
#define REP_P0 1
#endif
#ifndef REP_P1
#define REP_P1 1
#endif
#ifndef REP_P2
#define REP_P2 1
#endif
#ifndef REP_P3
#define REP_P3 1
#endif
#ifndef REP_P4
#define REP_P4 1
#endif
#ifndef REP_P5
#define REP_P5 1
#endif
#ifndef REP_P6
#define REP_P6 1
#endif
#ifndef REP_P7
#define REP_P7 1
#endif
#ifndef REP_P8
#define REP_P8 1
#endif
#ifndef REP_P9
#define REP_P9 1
#endif
#ifndef REP_P10
#define REP_P10 1
#endif
#ifndef REP_P11
#define REP_P11 1
#endif
#ifndef REP_P12
#define REP_P12 1
#endif

constexpr int NTHREADS = 512, NWAVES = 8;
constexpr int NB = 4, SEQ = 4096, NTOK = NB * SEQ, DM = 1024;
constexpr int HGW = 512, NHEAD = 4, HD = 128, CHUNK = 64, NCHUNK = SEQ / CHUNK;
constexpr int PROJW = 2560, GATEW = 2048, NPG = PROJW + GATEW;
constexpr int NEXP = 32, EFF = 512, PMAX = 40960;
constexpr float EPS = 1e-6f;

constexpr size_t MiB = 1u << 20;
constexpr size_t WS_CTL = 0, CTL_BYTES = 1 * MiB;
constexpr size_t WS_ADAP = 1 * MiB;
constexpr size_t WS_ADA = 2 * MiB;
constexpr size_t WS_ROUT = 3 * MiB;
constexpr size_t WS_TOK_E = WS_ROUT, WS_TOK_W = WS_ROUT + 128 * 1024, WS_TOK_RANK = WS_ROUT + 256 * 1024, WS_TOK_POS = WS_ROUT + 384 * 1024,
                 WS_WG_CNT = WS_ROUT + 512 * 1024, WS_PSTART = WS_ROUT + 544 * 1024, WS_ROW_TOK = WS_ROUT + 576 * 1024;
constexpr size_t WS_DEC = 4 * MiB;
constexpr size_t WS_OML = 5 * MiB;
constexpr size_t WS_WT_IN = 8 * MiB, WS_WT_BR = 17 * MiB, WS_WT_OUT = 19 * MiB;
constexpr size_t WS_WE1 = 24 * MiB, WS_WE2 = 88 * MiB;
constexpr size_t WS_A1 = 120 * MiB;
constexpr size_t WS_A2 = 200 * MiB;
constexpr size_t WS_A3 = 264 * MiB;
constexpr size_t WS_END = 296 * MiB;
constexpr int CW_BAR = 4096, CW_WORK = 8256;

constexpr int LDS_BYTES = 160 * 1024 - 512;
constexpr int MISC_OFF = LDS_BYTES - 256, PTAB_OFF = LDS_BYTES - 512, UT_OFF = LDS_BYTES - 1024;

typedef unsigned short bf16;
typedef float f32x4 __attribute__((ext_vector_type(4)));
typedef unsigned u32x2 __attribute__((ext_vector_type(2)));
typedef unsigned u32x4 __attribute__((ext_vector_type(4)));

DI float bf2f(bf16 b) { return __uint_as_float(((unsigned)b) << 16); }
typedef float f32x2_ __attribute__((ext_vector_type(2)));
typedef __bf16 bf16x2_ __attribute__((ext_vector_type(2)));
DI unsigned pk2(float lo, float hi) { const f32x2_ v = {lo, hi}; return __builtin_bit_cast(unsigned, __builtin_convertvector(v, bf16x2_)); }
DI unsigned f2bf(float f) { return pk2(f, 0.f) & 0xffffu; }
DI float lo_bf(unsigned w) { return __uint_as_float(w << 16); }
DI float hi_bf(unsigned w) { return __uint_as_float(w & 0xffff0000u); }
DI float wave_sum(float v) {
#pragma unroll
    for (int o = 1; o < 64; o <<= 1) v += __shfl_xor(v, o);
    return v;
}
DI float sigm(float x) { return __builtin_amdgcn_rcpf(1.0f + __expf(-x)); }
DI float silu(float x) { return x * sigm(x); }

DI int lane_id_opaque() { int l = (int)__builtin_amdgcn_mbcnt_hi(~0u, __builtin_amdgcn_mbcnt_lo(~0u, 0u)); asm volatile("" : "+v"(l)); return l; }

DI const void* ldp(LAS const unsigned long long* pt, int i) { const unsigned long long v = pt[i]; const unsigned lo = __builtin_amdgcn_readfirstlane((unsigned)v), hi = __builtin_amdgcn_readfirstlane((unsigned)(v >> 32)); return (const void*)(const GAS void*)(((unsigned long long)hi << 32) | lo); }

struct Args { const float* in[25]; float* out; unsigned char* ws; int ph_lo, ph_hi; };

namespace pg8 {
typedef short bf16x8 __attribute__((ext_vector_type(8)));
constexpr int BM = 256, BK = 64, HALF = 128, HTB = HALF * BK * 2, STAGE_BYTES = 8 * HTB, NXCD = 8, WGM = 8;
DI int lds_byte(int r, int c) { const int st = (r >> 4) * 2 + (c >> 5), rr = r & 15, cc = c & 31, ob = rr * 64 + cc * 2; return st * 1024 + (ob ^ (((ob >> 9) & 1) << 5)); }
DI void stage_rc(int b, int& R, int& C) { const int st = b / 1024, sb = b % 1024, swz = sb ^ (((sb >> 9) & 1) << 5); R = (st >> 1) * 16 + swz / 64; C = (st & 1) * 32 + (swz % 64) / 2; }
DI int perm32(int rho) { const int n = rho >> 4, i = rho & 15; return 8 * (i >> 2) + 4 * n + (i & 3); }
DI unsigned cvt_pk_bf16(float lo, float hi) { return pk2(lo, hi); }

struct Unit { const char* B; int pm, pn, e, row0, half; };
DI int xcd_remap(int wgid, int nwg) { const int q = nwg / NXCD, r = nwg % NXCD, xcd = wgid % NXCD, off = wgid / NXCD; return (xcd < r ? xcd * (q + 1) : r * (q + 1) + (xcd - r) * q) + off; }

struct DenseSched {
    const char* A; const char* Bt; int nM, nN, nwg, G, c, K;
    DI void init(const void* A_, const void* Bt_, int M, int N, int K_, int G_, int c_) { A = (const char*)A_; Bt = (const char*)Bt_; nM = M / BM; nN = N / BM; nwg = nM * nN; G = G_; c = c_; K = K_; }
    DI bool next(int i, Unit& u) const {
        const int L = i * G + c, nfull = (nwg / G) * G;
        int wgid, half = 0, hs = 0;
        if (L < nfull) wgid = xcd_remap(L, nfull);
        else { const int h = L - nfull; if (h >= 2 * (nwg - nfull)) return false; wgid = nfull + (h >> 1); half = 1; hs = h & 1; }
        const int nig = WGM * nN, gid = wgid / nig, fm = gid * WGM, gsz = (nM - fm) < WGM ? (nM - fm) : WGM;
        u.pm = fm + ((wgid % nig) % gsz); u.pn = (wgid % nig) / gsz; u.e = 0; u.B = Bt + (size_t)u.pn * BM * K * 2; u.half = half; u.row0 = u.pm * BM + hs * HALF; return true;
    }
    DI const char* abase() const { return A; }
    DI unsigned arow(const Unit& u, int r) const { return (unsigned)(u.row0 + (u.half ? (r & (HALF - 1)) : r)); }
};
template <bool GATHER> struct MoeSched {
    const char* A; const char* WT; const int* row_tok; LAS const int* ut; int K, nrows;
    DI void init(const void* A_, const void* WT_, const int* pstart_g, const int* row_tok_, int nN, int nrows_, int K_, int G, int c, LAS int* ut_, int tid) {
        const int* pstart = pstart_g;
        A = (const char*)A_; WT = (const char*)WT_; row_tok = row_tok_; nrows = nrows_; K = K_; ut = ut_;
        if (tid <= NEXP) ut_[92 + tid] = pstart[tid];
        __syncthreads();
        if (tid == 0) {
            LAS const int* pstart = ut_ + 92;
            const int nwg = (pstart[NEXP] / BM) * nN, nfull = (nwg / G) * G;
            for (int i = 0; i < 23; ++i) {
                const int L = i * G + c; int pm = -1, pn = 0, e = 0, hf = 0;
                int wgid = -1;
                if (L < nfull) wgid = xcd_remap(L, nfull);
                else { const int h = L - nfull; if (h < 2 * (nwg - nfull)) { wgid = nfull + (h >> 1); hf = 1 + (h & 1); } }
                if (wgid >= 0) { pm = wgid / nN; pn = wgid % nN; for (int q = 1; q < NEXP; ++q) if (pm * BM >= pstart[q]) e = q; }
                ut_[i * 4] = pm; ut_[i * 4 + 1] = pn; ut_[i * 4 + 2] = e; ut_[i * 4 + 3] = hf;
                if (pm < 0) break;
            }
        }
        __syncthreads();
    }
    DI bool next(int i, Unit& u) const {
        const int pm = __builtin_amdgcn_readfirstlane(ut[i * 4]); if (pm < 0) return false;
        u.pm = pm; u.pn = __builtin_amdgcn_readfirstlane(ut[i * 4 + 1]); u.e = __builtin_amdgcn_readfirstlane(ut[i * 4 + 2]);
        const int hf = __builtin_amdgcn_readfirstlane(ut[i * 4 + 3]); u.half = hf ? 1 : 0; u.row0 = pm * BM + (hf == 2 ? HALF : 0);
        u.B = WT + ((size_t)u.e * nrows + (size_t)u.pn * BM) * K * 2; return true;
    }
    DI const char* abase() const { return A; }
    DI unsigned arow(const Unit& u, int r) const { const int rr = u.row0 + (u.half ? (r & (HALF - 1)) : r); return GATHER ? (unsigned)row_tok[rr] : (unsigned)rr; }
};

template <int K, class Epi, class Sched>
DI void gemm_phase(LAS unsigned char* lds, const Sched& S, const Epi& E, int wave_sgpr) {
    const int lane = lane_id_opaque(), wid = wave_sgpr, tid = wid * 64 + lane, wr = wid >> 2, wc = wid & 3, fr = lane & 15, fq = lane >> 4;
    constexpr int nt = K / BK;
    int Rr[2], Cc[2]; unsigned voffB[2];
#pragma unroll
    for (int i = 0; i < 2; ++i) { int R, C; stage_rc(tid * 16 + i * 8192, R, C); Rr[i] = R; Cc[i] = C; const int Rb = Epi::PERM ? ((R & ~31) + perm32(R & 31)) : R; voffB[i] = (unsigned)(Rb * K + C) * 2u; }
    constexpr size_t kstep = (size_t)(BK * 2);
    constexpr size_t hstep = (size_t)HALF * K * 2;
    const unsigned ldsw = (unsigned)wid * 1024u;
    const int aoff = lds_byte(wr * 64 + fr, fq * 8), boff = lds_byte(wc * 32 + fr, fq * 8);
#define PG8_SA(b, h) (((b) * 2 + (h)) * HTB)
#define PG8_SB(b, h) ((4 + (b) * 2 + (h)) * HTB)
#define PG8_STAGE(bufoff, gbase, voff) do { _Pragma("unroll") for (int _i = 0; _i < 2; ++_i) \
        __builtin_amdgcn_global_load_lds((const unsigned*)((const char*)(gbase) + (voff)[_i]), (LAS unsigned*)(lds + (bufoff) + ldsw + _i * 8192), 16, 0, 0); } while (0)
#define PG8_LDA(dst, b, h) do { _Pragma("unroll") for (int m = 0; m < 4; ++m) _Pragma("unroll") for (int k = 0; k < 2; ++k) dst[m][k] = *(const LAS bf16x8*)(lds + PG8_SA(b, h) + aoff + m * 2048 + k * 1024); } while (0)
#define PG8_LDB(dst, b, h) do { _Pragma("unroll") for (int n = 0; n < 2; ++n) _Pragma("unroll") for (int k = 0; k < 2; ++k) dst[n][k] = *(const LAS bf16x8*)(lds + PG8_SB(b, h) + boff + n * 2048 + k * 1024); } while (0)
#define PG8_MMA(ai, bj, At, Bt) do { __builtin_amdgcn_s_setprio(1); _Pragma("unroll") for (int m = 0; m < 4; ++m) _Pragma("unroll") for (int n = 0; n < 2; ++n) _Pragma("unroll") for (int k = 0; k < 2; ++k) \
        acc[ai][bj][m][n] = __builtin_amdgcn_mfma_f32_16x16x32_bf16(Bt[n][k], At[m][k], acc[ai][bj][m][n], 0, 0, 0); __builtin_amdgcn_s_setprio(0); } while (0)
#define PG8_WAIT_V(n) asm volatile("s_waitcnt vmcnt(" #n ")" ::: "memory")
#define PG8_WAIT_L(n) asm volatile("s_waitcnt lgkmcnt(" #n ")" ::: "memory")
#define PG8_BAR __builtin_amdgcn_s_barrier()
#define PG8_SCHED __builtin_amdgcn_sched_barrier(0)
    Unit cur, nxt; int ui = 0;
    if (!S.next(0, cur)) return;
    f32x4 acc[2][2][4][2];
#pragma unroll
    for (int a = 0; a < 2; ++a)
#pragma unroll
        for (int b = 0; b < 2; ++b)
#pragma unroll
            for (int m = 0; m < 4; ++m)
#pragma unroll
                for (int n = 0; n < 2; ++n) acc[a][b][m][n] = (f32x4){0.f, 0.f, 0.f, 0.f};
    bf16x8 At[4][2], B0[2][2], B1[2][2];
    unsigned cv0[2], cv1[2], nv0[2], nv1[2];
#pragma unroll
    for (int i = 0; i < 2; ++i) { cv0[i] = (S.arow(cur, Rr[i]) * (unsigned)K + (unsigned)Cc[i]) * 2u; cv1[i] = (S.arow(cur, HALF + Rr[i]) * (unsigned)K + (unsigned)Cc[i]) * 2u; }
    const char* const cA = S.abase(); const char* cB = cur.B;
    PG8_STAGE(PG8_SB(0, 0), cB, voffB); PG8_STAGE(PG8_SB(0, 1), cB + hstep, voffB); PG8_STAGE(PG8_SA(0, 0), cA, cv0); PG8_STAGE(PG8_SA(0, 1), cA, cv1);
    if (wr == 1) PG8_BAR;
    PG8_WAIT_V(2); PG8_BAR;
    PG8_STAGE(PG8_SB(1, 0), cB + kstep, voffB); PG8_STAGE(PG8_SA(1, 0), cA + kstep, cv0); PG8_STAGE(PG8_SB(1, 1), cB + hstep + kstep, voffB);
    PG8_WAIT_V(6); PG8_BAR;
    for (;;) {
        const bool has_next = S.next(ui + 1, nxt);
        const char* nB = has_next ? nxt.B : cB;
#pragma unroll
        for (int i = 0; i < 2; ++i) { nv0[i] = has_next ? (S.arow(nxt, Rr[i]) * (unsigned)K + (unsigned)Cc[i]) * 2u : cv0[i]; nv1[i] = has_next ? (S.arow(nxt, HALF + Rr[i]) * (unsigned)K + (unsigned)Cc[i]) * 2u : cv1[i]; }
        for (int t = 0; t < nt; t += 2) {
            const bool last = (t == nt - 2);
            if constexpr (Epi::MID) { if (t == nt / 2) E.mid(acc, cur, wr, wc, fr, fq); }
            const char* a1 = cA + (size_t)(t + 1) * kstep;
            const char* a2 = last ? cA : cA + (size_t)(t + 2) * kstep; const char* b2 = last ? nB : cB + (size_t)(t + 2) * kstep;
            const char* a3 = a2 + kstep; const char* b3 = b2 + kstep;
            unsigned s0[2], s1[2];
#pragma unroll
            for (int i = 0; i < 2; ++i) { s0[i] = last ? nv0[i] : cv0[i]; s1[i] = last ? nv1[i] : cv1[i]; }
            PG8_LDB(B0, 0, 0); PG8_LDB(B1, 0, 1); PG8_SCHED; PG8_LDA(At, 0, 0); PG8_STAGE(PG8_SA(1, 1), a1, cv1);
            PG8_WAIT_V(8); PG8_WAIT_L(0); PG8_BAR; PG8_MMA(0, 0, At, B0); PG8_MMA(0, 1, At, B1); PG8_BAR; PG8_SCHED;
            PG8_LDA(At, 0, 1); PG8_STAGE(PG8_SB(0, 0), b2, voffB); PG8_STAGE(PG8_SB(0, 1), b2 + hstep, voffB); PG8_STAGE(PG8_SA(0, 0), a2, s0);
            PG8_WAIT_V(8); PG8_WAIT_L(0); PG8_BAR; if (!cur.half) { PG8_MMA(1, 0, At, B0); PG8_MMA(1, 1, At, B1); } PG8_BAR; PG8_SCHED;
            PG8_LDB(B0, 1, 0); PG8_LDB(B1, 1, 1); PG8_SCHED; PG8_LDA(At, 1, 0); PG8_STAGE(PG8_SA(0, 1), a2, s1);
            PG8_WAIT_V(8); PG8_WAIT_L(0); PG8_BAR; PG8_MMA(0, 0, At, B0); PG8_MMA(0, 1, At, B1); PG8_BAR; PG8_SCHED;
            PG8_LDA(At, 1, 1); PG8_STAGE(PG8_SB(1, 0), b3, voffB); PG8_STAGE(PG8_SB(1, 1), b3 + hstep, voffB); PG8_STAGE(PG8_SA(1, 0), a3, s0);
            PG8_WAIT_V(8); PG8_WAIT_L(0); PG8_BAR; if (!cur.half) { PG8_MMA(1, 0, At, B0); PG8_MMA(1, 1, At, B1); } PG8_BAR; PG8_SCHED;
        }
        if (wr == 0) PG8_BAR;
        E(acc, cur, wr, wc, fr, fq);
        if (!has_next) break;
#pragma unroll
        for (int a = 0; a < 2; ++a)
#pragma unroll
            for (int b = 0; b < 2; ++b)
#pragma unroll
                for (int m = 0; m < 4; ++m)
#pragma unroll
                    for (int n = 0; n < 2; ++n) acc[a][b][m][n] = (f32x4){0.f, 0.f, 0.f, 0.f};
        cur = nxt; cB = nB; ++ui;
#pragma unroll
        for (int i = 0; i < 2; ++i) { cv0[i] = nv0[i]; cv1[i] = nv1[i]; }
        if (wr == 1) PG8_BAR;
    }
    PG8_WAIT_V(0);
    PG8_BAR;
#undef PG8_SA
#undef PG8_SB
#undef PG8_STAGE
#undef PG8_LDA
#undef PG8_LDB
#undef PG8_MMA
#undef PG8_WAIT_V
#undef PG8_WAIT_L
#undef PG8_BAR
#undef PG8_SCHED
}

typedef f32x4 Acc[2][2][4][2];
DI u32x4 pack8(const f32x4& v0, const f32x4& v1) { u32x4 w; w.x = cvt_pk_bf16(v0[0], v0[1]); w.y = cvt_pk_bf16(v0[2], v0[3]); w.z = cvt_pk_bf16(v1[0], v1[1]); w.w = cvt_pk_bf16(v1[2], v1[3]); return w; }

struct EpiPlain {
    static constexpr bool PERM = true, MID = false;
    bf16* O; int ldc;
    DI void operator()(const Acc& acc, const Unit& u, int wr, int wc, int fr, int fq) const {
        int row0 = u.row0 + wr * 64 + fr, col0 = u.pn * BM + wc * 32 + 8 * fq; const int half = u.half;
        asm volatile("" : "+v"(row0));
#pragma unroll
        for (int ai = 0; ai < 2; ++ai) { if (ai == 1 && half) break;
#pragma unroll
            for (int m = 0; m < 4; ++m) { bf16* rowp = O + (size_t)(row0 + ai * HALF + m * 16) * ldc + col0;
#pragma unroll
                for (int bj = 0; bj < 2; ++bj) *(u32x4*)(rowp + bj * HALF) = pack8(acc[ai][bj][m][0], acc[ai][bj][m][1]); } }
    }
};
struct EpiProj {
    static constexpr bool PERM = true, MID = false;
    bf16* P; bf16* Gt; const float* oml; const float* b_gate;
    template <int TYPE> DI void run(const Acc& acc, bf16* base, int ldc, int row0, int col0, const float* cvp, int half) const {
        f32x4 cv[2][2];
#pragma unroll
        for (int bj = 0; bj < 2; ++bj)
#pragma unroll
            for (int n = 0; n < 2; ++n) cv[bj][n] = (TYPE == 1 || TYPE == 3) ? *(const f32x4*)(cvp + bj * HALF + 4 * n) : (f32x4){0.f, 0.f, 0.f, 0.f};
#pragma unroll
        for (int ai = 0; ai < 2; ++ai) { if (ai == 1 && half) break;
#pragma unroll
            for (int m = 0; m < 4; ++m) { bf16* rowp = base + (size_t)(row0 + ai * HALF + m * 16) * ldc + col0;
#pragma unroll
                for (int bj = 0; bj < 2; ++bj) { f32x4 v[2] = {acc[ai][bj][m][0], acc[ai][bj][m][1]};
#pragma unroll
                    for (int n = 0; n < 2; ++n)
#pragma unroll
                        for (int j = 0; j < 4; ++j) { const float t = v[n][j];
                            if (TYPE == 0) v[n][j] = silu(t); else if (TYPE == 1) v[n][j] = cv[bj][n][j] * sigm(-t); else if (TYPE == 3) v[n][j] = sigm(t + cv[bj][n][j]); }
                    *(u32x4*)(rowp + bj * HALF) = pack8(v[0], v[1]); } } }
    }
    DI void gates(const Acc& acc, const Unit& u, int wr, int wc, int fr, int fq) const {
        const int p = u.pn - 10, ch0 = p * HALF + wc * 32 + 8 * fq, wave = wr * 4 + wc, lane = fq * 16 + fr, ai0 = (u.row0 - u.pm * BM) >> 7;
        f32x4 b1[2], b2[2];
#pragma unroll
        for (int n = 0; n < 2; ++n) { b1[n] = *(const f32x4*)(b_gate + ch0 + 4 * n); b2[n] = *(const f32x4*)(b_gate + 1024 + ch0 + 4 * n); }
        size_t base = ((size_t)(u.pm * 8 + p) * 8 + wave) * 8 * 64 + lane;
        asm volatile("" : "+v"(base));
#pragma unroll
        for (int ai = 0; ai < 2; ++ai) { if (ai == 1 && u.half) break;
#pragma unroll
            for (int m = 0; m < 4; ++m) { f32x4 r[2], g[2];
#pragma unroll
                for (int n = 0; n < 2; ++n)
#pragma unroll
                    for (int j = 0; j < 4; ++j) { const float g1 = sigm(acc[ai][0][m][n][j] + b1[n][j]), g2 = fmaxf(sigm(acc[ai][1][m][n][j] + b2[n][j]), 1e-30f); g[n][j] = g2; r[n][j] = g1 * __builtin_amdgcn_rcpf(g2); }
                const size_t idx = base + (size_t)((ai0 + ai) * 4 + m) * 64;
                *((u32x4*)Gt + idx) = pack8(r[0], r[1]); *((u32x4*)Gt + (size_t)NTOK * DM / 8 + idx) = pack8(g[0], g[1]); } }
    }
    DI void operator()(const Acc& acc, const Unit& u, int wr, int wc, int fr, int fq) const {
        if (u.pn >= 10) { gates(acc, u, wr, wc, fr, fq); return; }
        int row0 = u.row0 + wr * 64 + fr; const int colt = u.pn * BM + wc * 32 + 8 * fq;
        asm volatile("" : "+v"(row0));
        if (u.pn < 2 || (u.pn >= 6 && u.pn < 8)) run<0>(acc, P, PROJW, row0, colt, nullptr, u.half);
        else if (u.pn < 4) run<1>(acc, P, PROJW, row0, colt, oml + (colt - 512), u.half);
        else run<2>(acc, P, PROJW, row0, colt, nullptr, u.half);
    }
};
struct EpiMix {
    static constexpr bool PERM = true, MID = true;
    bf16* O; const bf16* Gt;
    DI void mid(Acc& acc, const Unit& u, int wr, int wc, int fr, int fq) const {
        size_t base = ((size_t)(u.pm * 8 + 2 * u.pn) * 8 + (wr * 4 + wc)) * 8 * 64 + (fq * 16 + fr);
        asm volatile("" : "+v"(base));
        const u32x4* gp = (const u32x4*)Gt + base;
#pragma unroll
        for (int ai = 0; ai < 2; ++ai) {
            u32x4 rw[4][2];
#pragma unroll
            for (int m = 0; m < 4; ++m)
#pragma unroll
                for (int bj = 0; bj < 2; ++bj) rw[m][bj] = gp[(size_t)bj * 8 * 8 * 64 + (size_t)(ai * 4 + m) * 64];
            asm volatile("" : "+v"(rw[0][0]), "+v"(rw[0][1]), "+v"(rw[1][0]), "+v"(rw[1][1]), "+v"(rw[2][0]), "+v"(rw[2][1]), "+v"(rw[3][0]), "+v"(rw[3][1]));
#pragma unroll
            for (int m = 0; m < 4; ++m)
#pragma unroll
                for (int bj = 0; bj < 2; ++bj) { const unsigned w[4] = {rw[m][bj].x, rw[m][bj].y, rw[m][bj].z, rw[m][bj].w};
#pragma unroll
                    for (int n = 0; n < 2; ++n)
#pragma unroll
                        for (int j = 0; j < 4; ++j) { const unsigned a = w[n * 2 + (j >> 1)]; acc[ai][bj][m][n][j] *= (j & 1) ? hi_bf(a) : lo_bf(a); } }
        }
    }
    DI void operator()(const Acc& acc, const Unit& u, int wr, int wc, int fr, int fq) const {
        int row0 = u.row0 + wr * 64 + fr, col0 = u.pn * BM + wc * 32 + 8 * fq;
        size_t base = (size_t)NTOK * DM / 8 + ((size_t)(u.pm * 8 + 2 * u.pn) * 8 + (wr * 4 + wc)) * 8 * 64 + (fq * 16 + fr);
        asm volatile("" : "+v"(row0), "+v"(base));
        const u32x4* gp = (const u32x4*)Gt + base;
#pragma unroll
        for (int ai = 0; ai < 2; ++ai) {
            u32x4 gw[4][2];
#pragma unroll
            for (int m = 0; m < 4; ++m)
#pragma unroll
                for (int bj = 0; bj < 2; ++bj) gw[m][bj] = gp[(size_t)bj * 8 * 8 * 64 + (size_t)(ai * 4 + m) * 64];
            asm volatile("" : "+v"(gw[0][0]), "+v"(gw[0][1]), "+v"(gw[1][0]), "+v"(gw[1][1]), "+v"(gw[2][0]), "+v"(gw[2][1]), "+v"(gw[3][0]), "+v"(gw[3][1]));
#pragma unroll
            for (int m = 0; m < 4; ++m) { bf16* rowp = O + (size_t)(row0 + ai * HALF + m * 16) * DM + col0;
#pragma unroll
                for (int bj = 0; bj < 2; ++bj) { const unsigned w[4] = {gw[m][bj].x, gw[m][bj].y, gw[m][bj].z, gw[m][bj].w};
                    f32x4 v[2];
#pragma unroll
                    for (int n = 0; n < 2; ++n)
#pragma unroll
                        for (int j = 0; j < 4; ++j) { const unsigned b = w[n * 2 + (j >> 1)]; v[n][j] = acc[ai][bj][m][n][j] * ((j & 1) ? hi_bf(b) : lo_bf(b)); }
                    *(u32x4*)(rowp + bj * HALF) = pack8(v[0], v[1]); } }
        }
    }
};
struct EpiGlu {
    static constexpr bool PERM = true, MID = false;
    bf16* O;
    DI void operator()(const Acc& acc, const Unit& u, int wr, int wc, int fr, int fq) const {
        int row0 = u.row0 + wr * 64 + fr, col0 = u.pn * HALF + wc * 32 + 8 * fq; const int half = u.half;
        asm volatile("" : "+v"(row0));
#pragma unroll
        for (int ai = 0; ai < 2; ++ai) { if (ai == 1 && half) break;
#pragma unroll
            for (int m = 0; m < 4; ++m) { f32x4 v[2];
#pragma unroll
                for (int n = 0; n < 2; ++n)
#pragma unroll
                    for (int j = 0; j < 4; ++j) v[n][j] = silu(acc[ai][0][m][n][j]) * acc[ai][1][m][n][j];
                *(u32x4*)(O + (size_t)(row0 + ai * HALF + m * 16) * EFF + col0) = pack8(v[0], v[1]); } }
    }
};
}

#ifndef CONV_QK
#define CONV_QK 32
#endif
struct ConvPtrs { const float *w_in, *w_gate, *w_bhg, *w_out, *w_eg, *w_eu, *w_ed; bf16 *WT_IN, *WT_BR, *WT_OUT, *WE1, *WE2; };
constexpr int CONV_T_IN = 16 * 10, CONV_T_GATE = 16 * 8, CONV_T_BHG = 8 * 4, CONV_T_OUT = 16 * 4, CONV_T0 = CONV_T_IN + CONV_T_GATE + CONV_T_BHG + CONV_T_OUT, CONV_TE = 96, CONV_NTILES = CONV_T0 + NEXP * CONV_TE;
DI void conv_decode(const ConvPtrs& p, int it, const float*& srcp, int& N, bf16*& dstp, int& ldk, int& glu) {
    int r = it; glu = 0;
    if (r < CONV_T_IN) { const int kb = r / 10, nb = r % 10; N = PROJW; srcp = p.w_in + (size_t)kb * 64 * PROJW + nb * 256; dstp = p.WT_IN + (size_t)(nb * 256) * DM + kb * 64; ldk = DM; return; } r -= CONV_T_IN;
    if (r < CONV_T_GATE) { const int kb = r / 8, nb = r % 8; N = GATEW; srcp = p.w_gate + (size_t)kb * 64 * GATEW + nb * 256; dstp = p.WT_IN + (size_t)(PROJW + 512 * (nb & 3) + 128 * (nb >> 2)) * DM + kb * 64; ldk = DM; glu = 1; return; } r -= CONV_T_GATE;
    if (r < CONV_T_BHG) { const int kb = r / 4, nb = r % 4; N = DM; srcp = p.w_bhg + (size_t)kb * 64 * DM + nb * 256; dstp = p.WT_BR + (size_t)(nb * 256) * DM + kb * 64; ldk = DM; return; } r -= CONV_T_BHG;
    if (r < CONV_T_OUT) { const int kb = r / 4, nb = r % 4; N = DM; srcp = p.w_out + (size_t)kb * 64 * DM + nb * 256; dstp = p.WT_OUT + (size_t)(nb * 256) * DM + kb * 64; ldk = DM; return; } r -= CONV_T_OUT;
    const int e = r / CONV_TE; r %= CONV_TE;
    if (r < 64) { const int up = r >> 5, q = r & 31, kb = q >> 1, nb = q & 1; N = EFF; srcp = (up ? p.w_eu : p.w_eg) + (size_t)e * DM * EFF + (size_t)kb * 64 * EFF + nb * 256;
        dstp = p.WE1 + ((size_t)e * 1024 + nb * 512 + up * 128) * DM + kb * 64; ldk = DM; glu = 1; return; }
    { const int q = r - 64, kb = q >> 2, nb = q & 3; N = DM; srcp = p.w_ed + (size_t)e * EFF * DM + (size_t)kb * 64 * DM + nb * 256; dstp = p.WE2 + ((size_t)e * 1024 + nb * 256) * EFF + kb * 64; ldk = EFF; }
}
#define P0_ISSUE(PRE, IT, THI, DST, LDK, GLU) do { if ((IT) < (THI)) { const float* srcp_; int N_; conv_decode(p, (IT), srcp_, N_, DST, LDK, GLU); \
        _Pragma("unroll") for (int i = 0; i < 8; ++i) PRE[i] = *(const f32x4*)(srcp_ + (size_t)((tid >> 6) + 8 * i) * N_ + (tid & 63) * 4); } } while (0)
#define P0_STAGE(PRE, TLB) do { _Pragma("unroll") for (int i = 0; i < 8; ++i) { const int k = (tid >> 6) + 8 * i; *(LAS f32x4*)((TLB) + k * 256 + ((((tid & 63) ^ (k >> 3)) & 63) << 2)) = PRE[i]; } } while (0)
#define P0_EMIT(TLB, CD, CL, CG) do { const int c = tid & 7; _Pragma("unroll") for (int q = 0; q < 4; ++q) { const int n = (tid >> 3) + 64 * q; const int drow = (CG) ? ((n >> 7) * 256 + (n & 127)) : n; \
        const LAS float* s = (TLB) + (8 * c) * 256 + ((((n >> 2) ^ c) & 63) << 2) + (n & 3); \
        u32x4 o; o.x = pk2(s[0], s[256]); o.y = pk2(s[2 * 256], s[3 * 256]); o.z = pk2(s[4 * 256], s[5 * 256]); o.w = pk2(s[6 * 256], s[7 * 256]); \
        *(u32x4*)((CD) + (size_t)drow * (CL) + 8 * c) = o; } } while (0)
DI void convert_tiles(const ConvPtrs& p, LAS float* TL, int tid, int t_lo, int t_hi, int worker, int nworkers) {
    f32x4 pa[8], pb[8]; bf16* da = nullptr; bf16* db = nullptr; int la = 0, lb = 0, ga = 0, gb = 0;
    int it = t_lo + worker;
    P0_ISSUE(pa, it, t_hi, da, la, ga); P0_ISSUE(pb, it + nworkers, t_hi, db, lb, gb);
    LAS float* TL1 = TL + 64 * 256;
    while (it < t_hi) {
        { P0_STAGE(pa, TL); bf16* cd = da; const int cl = la, cg = ga; P0_ISSUE(pa, it + 2 * nworkers, t_hi, da, la, ga); __syncthreads(); P0_EMIT(TL, cd, cl, cg); }
        it += nworkers; if (it >= t_hi) break;
        { P0_STAGE(pb, TL1); bf16* cd = db; const int cl = lb, cg = gb; P0_ISSUE(pb, it + 2 * nworkers, t_hi, db, lb, gb); __syncthreads(); P0_EMIT(TL1, cd, cl, cg); }
        it += nworkers;
    }
    __syncthreads();
}
template <int KR> DI void convert_part(const ConvPtrs& p, LAS float* TL, int tid, int it, int part) {
    const float* srcp; int N; bf16* dst; int ldk, glu; conv_decode(p, it, srcp, N, dst, ldk, glu);
    constexpr int NL = KR / 8;
    f32x4 pa[NL];
#pragma unroll
    for (int i = 0; i < NL; ++i) pa[i] = *(const f32x4*)(srcp + (size_t)(part * KR + (tid >> 6) + 8 * i) * N + (tid & 63) * 4);
#pragma unroll
    for (int i = 0; i < NL; ++i) { const int k = (tid >> 6) + 8 * i; *(LAS f32x4*)(TL + k * 256 + ((((tid & 63) ^ (k >> 3)) & 63) << 2)) = pa[i]; }
    __syncthreads();
    const int c = tid % NL;
#pragma unroll
    for (int q = 0; q < (256 * NL) / 512; ++q) {
        const int n = (tid / NL) + (512 / NL) * q; const int drow = glu ? ((n >> 7) * 256 + (n & 127)) : n;
        const LAS float* s = TL + (8 * c) * 256 + ((((n >> 2) ^ c) & 63) << 2) + (n & 3);
        u32x4 o; o.x = pk2(s[0], s[256]); o.y = pk2(s[2 * 256], s[3 * 256]); o.z = pk2(s[4 * 256], s[5 * 256]); o.w = pk2(s[6 * 256], s[7 * 256]);
        *(u32x4*)(dst + (size_t)drow * ldk + part * KR + 8 * c) = o; }
    __syncthreads();
}
#undef P0_ISSUE
#undef P0_STAGE
#undef P0_EMIT

template <class W> DI void xcd_barrier_work(const XcdBarrier& b, volatile LAS unsigned* flagw, W&& work) {
    asm volatile("s_waitcnt vmcnt(0)" ::: "memory");
    __syncthreads();
    unsigned gen = 0;
    if (threadIdx.x == 0) {
        unsigned* bar = b.bar;
        __builtin_amdgcn_s_waitcnt(0);
        unsigned nloc = b.st[0], nx = b.st[1];
        if (nloc == 0u) { xcd_barrier_complete(bar, b.x, nloc, nx); b.st[0] = nloc; b.st[1] = nx; }
        const unsigned old = xb_add(&bar[XB_XSUB(b.x)], 1u);
        gen = old / nloc;
        if (old + 1u == (gen + 1u) * nloc) {
            __builtin_amdgcn_fence(__ATOMIC_RELEASE, "agent");
            asm volatile("s_waitcnt vmcnt(0)" ::: "memory");
            const unsigned og = xb_add(&bar[XB_TOP], 1u);
            const unsigned tg = og / nx;
            if (og + 1u == (tg + 1u) * nx) xb_add(&bar[XB_TOPGEN], 1u);
            else XB_SPIN(xb_ld(&bar[XB_TOPGEN]) == tg, bar);
            __builtin_amdgcn_fence(__ATOMIC_ACQUIRE, "agent");
            xb_add(&bar[XB_XGEN(b.x)], 1u);
            asm volatile("s_waitcnt vmcnt(0)" ::: "memory");
            flagw[0] = 1u;
        } else if (xb_ld(&bar[XB_XGEN(b.x)]) != gen) { __builtin_amdgcn_fence(__ATOMIC_ACQUIRE, "agent"); asm volatile("s_waitcnt vmcnt(0)" ::: "memory"); flagw[0] = 1u; }
        else flagw[0] = 0u;
    }
    unsigned polls = 0;
    for (;;) {
        __syncthreads();
        const unsigned f = flagw[0];
        if (f) break;
        const bool did = work();
        __syncthreads();
        if (threadIdx.x == 0) {
            unsigned* bar = b.bar; bool rel = xb_ld(&bar[XB_XGEN(b.x)]) != gen;
            if (!rel && !did) { __builtin_amdgcn_s_sleep(1); if ((++polls & 255u) == 0u) { if (xb_ld(&bar[XB_TMO])) rel = true; else if (polls > XB_SPIN_CAP) { atomicAdd(&bar[XB_TMO], 1u); rel = true; } } }
            if (rel) { __builtin_amdgcn_fence(__ATOMIC_ACQUIRE, "agent"); asm volatile("s_waitcnt vmcnt(0)" ::: "memory"); flagw[0] = 1u; }
        }
    }
}

__global__ void __launch_bounds__(NTHREADS, 2) mk_fwd(Args a) {
    extern __shared__ __attribute__((aligned(16))) unsigned char lds[];
    LAS unsigned char* L = (LAS unsigned char*)lds;
    volatile LAS unsigned* MISC = (volatile LAS unsigned*)(L + MISC_OFF);
    const int wave0 = __builtin_amdgcn_readfirstlane(threadIdx.x >> 6);
    const int G = gridDim.x, bid = blockIdx.x;
    if (threadIdx.x < 64) MISC[threadIdx.x] = 0u;
    if (threadIdx.x == 0) {
        LAS unsigned long long* pt = (LAS unsigned long long*)(L + PTAB_OFF);
#pragma unroll
        for (int i = 0; i < 25; ++i) pt[i] = (unsigned long long)a.in[i];
        pt[25] = (unsigned long long)a.out; pt[26] = (unsigned long long)a.ws;
    }
    __syncthreads();
    XcdBarrier bar = xcd_barrier_post((unsigned*)(a.ws + WS_CTL) + CW_BAR, MISC + 8);
#define GRID_BAR() xcd_barrier(bar)
#define CONV_WORK_BODY() \
        const int tidw = wave0 * 64 + lane_id_opaque(); \
        unsigned paw_ = PTAB_OFF; asm volatile("" : "+s"(paw_)); LAS const unsigned long long* PT_ = (LAS const unsigned long long*)(L + paw_); \
        unsigned char* wsw = LDP(unsigned char, 26); \
        const ConvPtrs cpw{nullptr, nullptr, nullptr, nullptr, LDP(const float, 22), LDP(const float, 23), LDP(const float, 24), nullptr, nullptr, nullptr, (bf16*)(wsw + WS_WE1), (bf16*)(wsw + WS_WE2)}; \
        unsigned claimed_ = 0u; \
        auto workfn = [&]() -> bool { \
            if (tidw == 0) MISC[17] = __hip_atomic_fetch_add((unsigned*)(wsw + WS_CTL) + CW_WORK, 1u, __ATOMIC_RELAXED, __HIP_MEMORY_SCOPE_AGENT); \
            __syncthreads(); \
            const unsigned t = MISC[17]; \
            claimed_ = t; \
            if (t >= (unsigned)(NEXP * CONV_TE * (64 / CONV_QK))) return false; \
            const int dt_ = (int)(t / (64 / CONV_QK));                      \
            const int it_ = CONV_T0 + (dt_ < NEXP * 64 ? (dt_ >> 6) * CONV_TE + (dt_ & 63) : ((dt_ - NEXP * 64) >> 5) * CONV_TE + 64 + ((dt_ - NEXP * 64) & 31)); \
            convert_part<CONV_QK>(cpw, (LAS float*)L, tidw, it_, (int)(t % (64 / CONV_QK))); \
            return true; }
#define GRID_BAR_W() do { CONV_WORK_BODY(); xcd_barrier_work(bar, MISC + 16, workfn); } while (0)
#define GRID_BAR_DRAIN(LIM) do { CONV_WORK_BODY(); while (workfn() && claimed_ < (unsigned)(LIM)) { } xcd_barrier(bar); } while (0)
#define LDP(T, i) ((T*)ldp(PT_, (i)))
#define PHASE_IDS() const int lane = lane_id_opaque(), wave = wave0, tid = wave * 64 + lane; (void)lane; (void)wave; (void)tid; \
    unsigned pa_ = PTAB_OFF; asm volatile("" : "+s"(pa_)); LAS const unsigned long long* PT_ = (LAS const unsigned long long*)(L + pa_); \
    [[maybe_unused]] const float* x = LDP(const float, 0); [[maybe_unused]] const float* cvec = LDP(const float, 1); [[maybe_unused]] const float* w_ada = LDP(const float, 2); [[maybe_unused]] const float* b_ada = LDP(const float, 3); \
    [[maybe_unused]] const float* g_pre_mix = LDP(const float, 4); [[maybe_unused]] const float* g_post_mix = LDP(const float, 5); [[maybe_unused]] const float* w_in = LDP(const float, 6); [[maybe_unused]] const float* lb_logits = LDP(const float, 7); \
    [[maybe_unused]] const float* hg_norm_g = LDP(const float, 8); [[maybe_unused]] const float* pool_w = LDP(const float, 9); [[maybe_unused]] const float* pool_scale = LDP(const float, 10); [[maybe_unused]] const float* w_bhg = LDP(const float, 11); \
    [[maybe_unused]] const float* w_bpool = LDP(const float, 12); [[maybe_unused]] const float* w_gate = LDP(const float, 13); [[maybe_unused]] const float* b_gate = LDP(const float, 14); [[maybe_unused]] const float* w_out = LDP(const float, 15); \
    [[maybe_unused]] const float* g_pre_ffn = LDP(const float, 16); [[maybe_unused]] const float* g_post_ffn = LDP(const float, 17); [[maybe_unused]] const float* w_rg = LDP(const float, 18); [[maybe_unused]] const float* b_rg = LDP(const float, 19); \
    [[maybe_unused]] const float* w_re = LDP(const float, 20); [[maybe_unused]] const float* b_re = LDP(const float, 21); [[maybe_unused]] const float* w_eg = LDP(const float, 22); [[maybe_unused]] const float* w_eu = LDP(const float, 23); [[maybe_unused]] const float* w_ed = LDP(const float, 24); \
    [[maybe_unused]] float* out = LDP(float, 25); [[maybe_unused]] unsigned char* ws = LDP(unsigned char, 26); \
    [[maybe_unused]] float* ADAP = (float*)(ws + WS_ADAP); [[maybe_unused]] float* ADA = (float*)(ws + WS_ADA); \
    [[maybe_unused]] int* TOK_E = (int*)(ws + WS_TOK_E); [[maybe_unused]] float* TOK_W = (float*)(ws + WS_TOK_W); [[maybe_unused]] int* TOK_RANK = (int*)(ws + WS_TOK_RANK); [[maybe_unused]] int* TOK_POS = (int*)(ws + WS_TOK_POS); \
    [[maybe_unused]] int* WG_CNT = (int*)(ws + WS_WG_CNT); [[maybe_unused]] int* PSTART = (int*)(ws + WS_PSTART); [[maybe_unused]] int* ROW_TOK = (int*)(ws + WS_ROW_TOK); \
    [[maybe_unused]] bf16* PROJ = (bf16*)(ws + WS_A1); [[maybe_unused]] bf16* MIX = (bf16*)(ws + WS_A1); [[maybe_unused]] bf16* YB = (bf16*)(ws + WS_A1); \
    [[maybe_unused]] bf16* GATE = (bf16*)(ws + WS_A2); [[maybe_unused]] bf16* HMID = (bf16*)(ws + WS_A2); \
    [[maybe_unused]] bf16* HN = (bf16*)(ws + WS_A3); [[maybe_unused]] bf16* MM = (bf16*)(ws + WS_A3); [[maybe_unused]] bf16* HN2 = (bf16*)(ws + WS_A3); \
    [[maybe_unused]] bf16* HP = (bf16*)out; \
    [[maybe_unused]] float* OML = (float*)(ws + WS_OML); \
    [[maybe_unused]] bf16* WT_IN = (bf16*)(ws + WS_WT_IN); [[maybe_unused]] bf16* WT_BR = (bf16*)(ws + WS_WT_BR); [[maybe_unused]] bf16* WT_OUT = (bf16*)(ws + WS_WT_OUT); [[maybe_unused]] bf16* WE1 = (bf16*)(ws + WS_WE1); [[maybe_unused]] bf16* WE2 = (bf16*)(ws + WS_WE2)

    LAS float* Lf = (LAS float*)L;

    for (int rep_ = 0; rep_ < REP_P0; ++rep_) { PHASE_IDS();
    for (int item = bid; item < 24 * 8; item += G) {
        const int chunk = item % 24, ks = item / 24, col = chunk * 256 + (tid & 255), kh = tid >> 8, kb = ks * 128 + kh * 64;
        LAS float* CL = Lf + 1024;
        for (int i = tid; i < 4 * DM; i += NTHREADS) CL[i] = silu(cvec[i]);
        __syncthreads();
        float acc[4] = {0.f, 0.f, 0.f, 0.f};
        for (int k0 = kb; k0 < kb + 64; k0 += 16) {
            float w[16];
#pragma unroll
            for (int j = 0; j < 16; ++j) w[j] = w_ada[(size_t)(k0 + j) * 6144 + col];
            __builtin_amdgcn_sched_barrier(0);
#pragma unroll
            for (int j = 0; j < 16; ++j)
#pragma unroll
                for (int b = 0; b < 4; ++b) acc[b] += CL[b * DM + k0 + j] * w[j];
        }
        if (kh == 1) {
#pragma unroll
            for (int b = 0; b < 4; ++b) Lf[b * 256 + (tid & 255)] = acc[b];
        }
        __syncthreads();
        if (kh == 0) {
#pragma unroll
            for (int b = 0; b < 4; ++b) ADAP[((size_t)ks * 4 + b) * 6144 + col] = acc[b] + Lf[b * 256 + (tid & 255)];
        }
        __syncthreads();
    }
    {
        const ConvPtrs cp{w_in, w_gate, w_bhg, w_out, w_eg, w_eu, w_ed, WT_IN, WT_BR, WT_OUT, WE1, WE2};
        convert_tiles(cp, Lf, tid, 0, CONV_T0, bid, G);
        for (int i = bid * NTHREADS + tid; i < 512; i += G * NTHREADS) OML[i] = 1.0f - 1.0f / (1.0f + __expf(lb_logits[512 + i] - lb_logits[i]));
        for (int blk = G - 1 - bid; blk < 128; blk += G) {
            const int n = (blk & 1) * 512 + tid, cb = blk >> 1, g = cb >> 4;
            LAS float* PWL = Lf;
            __syncthreads();
            for (int i = tid; i < 1024; i += NTHREADS) PWL[i] = pool_w[(size_t)(cb * 8) * 128 + i] * pool_scale[g * 128 + (i & 127)];
            __syncthreads();
            float acc8[8];
#pragma unroll
            for (int j = 0; j < 8; ++j) acc8[j] = 0.f;
            const float* wb = w_bpool + (size_t)(g * 128) * DM + n;
            for (int d0 = 0; d0 < 128; d0 += 16) {
                float w[16];
#pragma unroll
                for (int q = 0; q < 16; ++q) w[q] = wb[(size_t)(d0 + q) * DM];
                __builtin_amdgcn_sched_barrier(0);
#pragma unroll
                for (int q = 0; q < 16; ++q)
#pragma unroll
                    for (int j = 0; j < 8; ++j) acc8[j] += PWL[j * 128 + d0 + q] * w[q];
            }
            u32x4 o; o.x = pk2(acc8[0], acc8[1]); o.y = pk2(acc8[2], acc8[3]); o.z = pk2(acc8[4], acc8[5]); o.w = pk2(acc8[6], acc8[7]);
            *(u32x4*)(WT_BR + (size_t)n * DM + 512 + cb * 8) = o;
        }
    }
    }
    GRID_BAR_W();

    for (int rep_ = 0; rep_ < REP_P1; ++rep_) { PHASE_IDS();
    for (int i = bid * NTHREADS + tid; i < 4 * 6144; i += G * NTHREADS) {
        float s = b_ada[i % 6144];
#pragma unroll
        for (int ks = 0; ks < 8; ++ks) s += ADAP[(size_t)ks * 4 * 6144 + i];
        ADA[i] = s;
    }
    for (int rb = bid; rb < NTOK / 64; rb += G) {
        const int b = rb / 64;
        for (int j = tid; j < 2048; j += NTHREADS) {
            float s = b_ada[j];
#pragma unroll
            for (int ks = 0; ks < 8; ++ks) s += ADAP[((size_t)ks * 4 + b) * 6144 + j];
            Lf[j] = (j >= 1024) ? 1.0f + s : s;
        }
        __syncthreads();
        for (int rr0 = wave * 8; rr0 < wave * 8 + 8; rr0 += 4) {
            f32x4 v[4][4]; float ss[4];
#pragma unroll
            for (int q = 0; q < 4; ++q) { const f32x4* xr = (const f32x4*)(x + (size_t)(rb * 64 + rr0 + q) * DM) + lane; ss[q] = 0.f;
#pragma unroll
                for (int i = 0; i < 4; ++i) v[q][i] = xr[64 * i]; }
#pragma unroll
            for (int q = 0; q < 4; ++q)
#pragma unroll
                for (int i = 0; i < 4; ++i) ss[q] += (v[q][i].x * v[q][i].x + v[q][i].y * v[q][i].y) + (v[q][i].z * v[q][i].z + v[q][i].w * v[q][i].w);
#pragma unroll
            for (int o = 1; o < 64; o <<= 1) {
#pragma unroll
                for (int q = 0; q < 4; ++q) ss[q] += __shfl_xor(ss[q], o); }
#pragma unroll
            for (int q = 0; q < 4; ++q) {
                const float rstd = rsqrtf(ss[q] * (1.0f / DM) + EPS);
                u32x2* o = (u32x2*)(HN + (size_t)(rb * 64 + rr0 + q) * DM) + lane;
#pragma unroll
                for (int i = 0; i < 4; ++i) {
                    const int e = i * 256 + lane * 4;
                    const f32x4 g = *(const f32x4*)(g_pre_mix + e);
                    const float y0 = v[q][i].x * rstd * g.x * Lf[1024 + e] + Lf[e], y1 = v[q][i].y * rstd * g.y * Lf[1024 + e + 1] + Lf[e + 1];
                    const float y2 = v[q][i].z * rstd * g.z * Lf[1024 + e + 2] + Lf[e + 2], y3 = v[q][i].w * rstd * g.w * Lf[1024 + e + 3] + Lf[e + 3];
                    u32x2 w; w.x = pk2(y0, y1); w.y = pk2(y2, y3); o[64 * i] = w;
                }
            }
        }
        __syncthreads();
    }
    }
    GRID_BAR_W();

    for (int rep_ = 0; rep_ < REP_P2; ++rep_) { PHASE_IDS();
    { pg8::DenseSched S; S.init(HN, WT_IN, NTOK, NPG, DM, G, bid); pg8::EpiProj E{PROJ, GATE, OML, b_gate}; pg8::gemm_phase<1024>(L, S, E, wave0); }
    }
    GRID_BAR_W();

    for (int rep_ = 0; rep_ < REP_P3; ++rep_) { PHASE_IDS();
        typedef short bf16x8 __attribute__((ext_vector_type(8)));
        const int sub = wave >> 2, st = tid & 255, w4 = wave & 3, fr = lane & 15, fq = lane >> 4;
        LAS unsigned char* KT = L + sub * 36864; LAS unsigned char* VT = KT + 18432;
        bf16* ST = (bf16*)(ws + WS_A3); float* DEC = (float*)(ws + WS_DEC); float* DECM = DEC + 1024 * 128;
        for (int u0 = bid * 2; u0 < NB * NHEAD * NCHUNK; u0 += G * 2) {
            const int u = u0 + sub, bh = u >> 6, c = u & 63, b = bh >> 2, h = bh & 3;
            const size_t row0 = (size_t)b * SEQ + (size_t)c * CHUNK;
            {
                const int k = st & 127, hf = st >> 7;
                const bf16* src = PROJ + row0 * PROJW + 512 + h * HD + k; const bf16* vp = src + 512 + (size_t)(hf * 32) * PROJW;
                unsigned kr[32], k2[32], vr[32];
#pragma unroll
                for (int s = 0; s < 32; ++s) { kr[s] = src[(size_t)(hf * 32 + s) * PROJW]; vr[s] = vp[(size_t)s * PROJW]; k2[s] = src[(size_t)(32 + s) * PROJW]; }
                __builtin_amdgcn_sched_barrier(0);
                float t2 = 0.f;
                if (hf == 0) {
#pragma unroll
                    for (int s = 0; s < 32; ++s) t2 += __logf(1.0f - __uint_as_float(k2[s] << 16));
                }
                float suf = t2;
#pragma unroll
                for (int g8 = 3; g8 >= 0; --g8) {
                    float kh[8];
#pragma unroll
                    for (int j = 7; j >= 0; --j) { const float kk = __uint_as_float(kr[g8 * 8 + j] << 16); kh[j] = kk * __expf(suf); suf += __logf(1.0f - kk); }
                    u32x4 w; w.x = pk2(kh[0], kh[1]); w.y = pk2(kh[2], kh[3]); w.z = pk2(kh[4], kh[5]); w.w = pk2(kh[6], kh[7]);
                    *(LAS u32x4*)(KT + k * 144 + (hf * 32 + g8 * 8) * 2) = w;
                }
                if (hf == 0) { DEC[u * 128 + k] = __expf(suf); DECM[u * 128 + k] = __expf(suf - t2); }
#pragma unroll
                for (int g8 = 0; g8 < 4; ++g8) {
                    u32x4 w; w.x = vr[g8 * 8] | (vr[g8 * 8 + 1] << 16); w.y = vr[g8 * 8 + 2] | (vr[g8 * 8 + 3] << 16); w.z = vr[g8 * 8 + 4] | (vr[g8 * 8 + 5] << 16); w.w = vr[g8 * 8 + 6] | (vr[g8 * 8 + 7] << 16);
                    *(LAS u32x4*)(VT + k * 144 + (hf * 32 + g8 * 8) * 2) = w;
                }
            }
            __syncthreads();
            f32x4 acc[2][8];
#pragma unroll
            for (int i = 0; i < 2; ++i)
#pragma unroll
                for (int vb = 0; vb < 8; ++vb) acc[i][vb] = (f32x4){0.f, 0.f, 0.f, 0.f};
#pragma unroll
            for (int ks = 0; ks < 2; ++ks) {
                bf16x8 af[2];
#pragma unroll
                for (int i = 0; i < 2; ++i) af[i] = *(const LAS bf16x8*)(KT + (16 * (2 * w4 + i) + fr) * 144 + (32 * ks + 8 * fq) * 2);
#pragma unroll
                for (int vb = 0; vb < 8; ++vb) { const bf16x8 bfv = *(const LAS bf16x8*)(VT + (16 * vb + fr) * 144 + (32 * ks + 8 * fq) * 2);
#pragma unroll
                    for (int i = 0; i < 2; ++i) acc[i][vb] = __builtin_amdgcn_mfma_f32_16x16x32_bf16(af[i], bfv, acc[i][vb], 0, 0, 0); }
            }
#pragma unroll
            for (int i = 0; i < 2; ++i)
#pragma unroll
                for (int vb = 0; vb < 8; ++vb) { u32x2 w; w.x = pk2(acc[i][vb][0], acc[i][vb][1]); w.y = pk2(acc[i][vb][2], acc[i][vb][3]);
                    *(u32x2*)(ST + (size_t)u * 16384 + (16 * vb + fr) * 128 + 16 * (2 * w4 + i) + 4 * fq) = w; }
            __syncthreads();
        }
        for (int run = bid * NWAVES + wave; run < NTOK / 8; run += G * NWAVES) {
            const int m0 = run * 8, t0 = m0 & (SEQ - 1), w = 2 << (lane >> 4);
            u32x4 rows[23];
#pragma unroll
            for (int j = 0; j < 23; ++j) { const int t = t0 - 15 + j; rows[j] = (t >= 0) ? *(const u32x4*)(PROJ + (size_t)(m0 - 15 + j) * PROJW + 2048 + lane * 8) : (u32x4){0u, 0u, 0u, 0u}; }
#define ROWV(j, q) (((q) & 1) ? hi_bf(((q) >> 1) == 0 ? rows[j].x : (((q) >> 1) == 1 ? rows[j].y : (((q) >> 1) == 2 ? rows[j].z : rows[j].w))) : lo_bf(((q) >> 1) == 0 ? rows[j].x : (((q) >> 1) == 1 ? rows[j].y : (((q) >> 1) == 2 ? rows[j].z : rows[j].w))))
            float S[8];
#pragma unroll
            for (int q = 0; q < 8; ++q) S[q] = 0.f;
#pragma unroll
            for (int j = 0; j < 15; ++j) { const bool in = (15 - j) < w;
#pragma unroll
                for (int q = 0; q < 8; ++q) S[q] += in ? ROWV(j, q) : 0.f; }
#pragma unroll
            for (int s = 0; s < 8; ++s) {
                const int j = 15 + s, t = t0 + s; const int cnt = (t + 1 < w) ? t + 1 : w; const float inv = 1.0f / (float)cnt;
                float y[8];
#pragma unroll
                for (int q = 0; q < 8; ++q) {
                    const float u = ROWV(j, q); S[q] += u; y[q] = S[q] * inv - u;
                    const float r1 = ROWV(j - 1, q), r3 = ROWV(j - 3, q), r7 = ROWV(j - 7, q), r15 = ROWV(j - 15, q);
                    S[q] -= (w == 2) ? r1 : ((w == 4) ? r3 : ((w == 8) ? r7 : r15));
                }
                u32x4 o; o.x = pk2(y[0], y[1]); o.y = pk2(y[2], y[3]); o.z = pk2(y[4], y[5]); o.w = pk2(y[6], y[7]);
                *(u32x4*)(HP + (size_t)(m0 + s) * DM + 512 + lane * 8) = o;
            }
#undef ROWV
        }
    }
    GRID_BAR_W();

    for (int rep_ = 0; rep_ < REP_P4; ++rep_) { PHASE_IDS();
        bf16* ST = (bf16*)(ws + WS_A3); const float* DEC = (const float*)(ws + WS_DEC); const float* DECM = DEC + 1024 * 128;
        typedef float f32x2 __attribute__((ext_vector_type(2)));
        for (int g = bid * NTHREADS + tid; g < NB * NHEAD * 128 * 64; g += G * NTHREADS) {
            const int kp = g & 63, v = (g >> 6) & 127, bh = g >> 13;
            unsigned* stp = (unsigned*)(ST + ((size_t)bh * 64 * 128 + v) * 128 + 2 * kp);
            const float* dp = DEC + (size_t)bh * 64 * 128 + 2 * kp; const float* mp = DECM + (size_t)bh * 64 * 128 + 2 * kp;
            float s0 = 0.f, s1 = 0.f;
            for (int c0 = 0; c0 < NCHUNK; c0 += 8) {
                unsigned kv[8]; f32x2 d[8], m[8];
#pragma unroll
                for (int j = 0; j < 8; ++j) { kv[j] = stp[(size_t)(c0 + j) * 8192]; d[j] = *(const f32x2*)(dp + (c0 + j) * 128); m[j] = *(const f32x2*)(mp + (c0 + j) * 128); }
#pragma unroll
                for (int j = 0; j < 8; ++j) { stp[(size_t)(c0 + j) * 8192] = pk2(s0 * m[j].x, s1 * m[j].y); s0 = d[j].x * s0 + lo_bf(kv[j]); s1 = d[j].y * s1 + hi_bf(kv[j]); }
            }
        }
    }
    GRID_BAR_W();

    for (int rep_ = 0; rep_ < REP_P5; ++rep_) { PHASE_IDS();
        typedef short bf16x8 __attribute__((ext_vector_type(8)));
        typedef short s16x4 __attribute__((ext_vector_type(4)));
        const int sub = wave >> 2, st = tid & 255, w4 = wave & 3, fr = lane & 15, fq = lane >> 4;
        LAS unsigned char* QS = L + sub * 53248; LAS unsigned char* KS = QS + 17408; LAS unsigned char* VT = KS + 17408;
        const bf16* ST = (const bf16*)(ws + WS_A3);
        for (int u0 = bid * 2; u0 < NB * NHEAD * NCHUNK; u0 += G * 2) {
            const int u = u0 + sub, bh = u >> 6, c = u & 63, b = bh >> 2, h = bh & 3;
            const size_t row0 = (size_t)b * SEQ + (size_t)c * CHUNK;
            {
                const int k = st & 127, hf = st >> 7;
                const bf16* kp = PROJ + (row0 + hf * 32) * PROJW + 512 + h * HD + k; const bf16* qp = kp - 512; const bf16* vp = kp + 512;
                unsigned kr[32], qr[32], vr[32];
#pragma unroll
                for (int s = 0; s < 32; ++s) { kr[s] = kp[(size_t)s * PROJW]; qr[s] = qp[(size_t)s * PROJW]; vr[s] = vp[(size_t)s * PROJW]; }
                __builtin_amdgcn_sched_barrier(0);
                if (hf == 1) {
                    float cs = 0.f;
#pragma unroll
                    for (int s = 0; s < 32; ++s) { const float kk = __uint_as_float(kr[s] << 16), q = __uint_as_float(qr[s] << 16); cs += __logf(1.0f - kk);
                        *(LAS bf16*)(QS + (32 + s) * 272 + k * 2) = (bf16)f2bf(q * __expf(cs)); *(LAS bf16*)(KS + (32 + s) * 272 + k * 2) = (bf16)f2bf(kk * __expf(-cs)); }
                } else {
                    float d = 0.f;
#pragma unroll
                    for (int s = 31; s >= 0; --s) { const float kk = __uint_as_float(kr[s] << 16), q = __uint_as_float(qr[s] << 16);
                        *(LAS bf16*)(QS + s * 272 + k * 2) = (bf16)f2bf(q * __expf(-d)); *(LAS bf16*)(KS + s * 272 + k * 2) = (bf16)f2bf(kk * __expf(d)); d += __logf(1.0f - kk); }
                }
#pragma unroll
                for (int g8 = 0; g8 < 4; ++g8) {
                    u32x4 w; w.x = vr[g8 * 8] | (vr[g8 * 8 + 1] << 16); w.y = vr[g8 * 8 + 2] | (vr[g8 * 8 + 3] << 16); w.z = vr[g8 * 8 + 4] | (vr[g8 * 8 + 5] << 16); w.w = vr[g8 * 8 + 6] | (vr[g8 * 8 + 7] << 16);
                    *(LAS u32x4*)(VT + k * 144 + (hf * 32 + g8 * 8) * 2) = w;
                }
            }
            __syncthreads();
            const int tb = w4;
            bf16x8 sf[4][8];
#pragma unroll
            for (int ks = 0; ks < 4; ++ks)
#pragma unroll
                for (int vb = 0; vb < 8; ++vb) sf[ks][vb] = *(const bf16x8*)(ST + (size_t)u * 16384 + (16 * vb + fr) * 128 + 32 * ks + 8 * fq);
            __builtin_amdgcn_sched_barrier(0);
            bf16x8 qf[4];
#pragma unroll
            for (int ks = 0; ks < 4; ++ks) qf[ks] = *(const LAS bf16x8*)(QS + (16 * tb + fr) * 272 + (32 * ks + 8 * fq) * 2);
            f32x4 sc[4];
#pragma unroll
            for (int sb = 0; sb < 4; ++sb) {
                sc[sb] = (f32x4){0.f, 0.f, 0.f, 0.f};
                if (sb <= tb) {
#pragma unroll
                    for (int ks = 0; ks < 4; ++ks) { const bf16x8 kf = *(const LAS bf16x8*)(KS + (16 * sb + fr) * 272 + (32 * ks + 8 * fq) * 2); sc[sb] = __builtin_amdgcn_mfma_f32_16x16x32_bf16(kf, qf[ks], sc[sb], 0, 0, 0); }
                    if (sb == tb) {
#pragma unroll
                        for (int r = 0; r < 4; ++r) if (4 * fq + r > fr) sc[sb][r] = 0.f;
                    }
                }
            }
            f32x4 o[8];
#pragma unroll
            for (int vb = 0; vb < 8; ++vb) o[vb] = (f32x4){0.f, 0.f, 0.f, 0.f};
#pragma unroll
            for (int p = 0; p < 2; ++p) {
                if (2 * p <= tb) {
                    u32x4 pw; pw.x = pk2(sc[2 * p][0], sc[2 * p][1]); pw.y = pk2(sc[2 * p][2], sc[2 * p][3]); pw.z = pk2(sc[2 * p + 1][0], sc[2 * p + 1][1]); pw.w = pk2(sc[2 * p + 1][2], sc[2 * p + 1][3]);
                    const bf16x8 pf = __builtin_bit_cast(bf16x8, pw);
#pragma unroll
                    for (int vb = 0; vb < 8; ++vb) {
                        const s16x4 lo = *(const LAS s16x4*)(VT + (16 * vb + fr) * 144 + (32 * p + 4 * fq) * 2), hi = *(const LAS s16x4*)(VT + (16 * vb + fr) * 144 + (32 * p + 16 + 4 * fq) * 2);
                        const bf16x8 vf = __builtin_shufflevector(lo, hi, 0, 1, 2, 3, 4, 5, 6, 7);
                        o[vb] = __builtin_amdgcn_mfma_f32_16x16x32_bf16(vf, pf, o[vb], 0, 0, 0);
                    }
                }
            }
#pragma unroll
            for (int ks = 0; ks < 4; ++ks)
#pragma unroll
                for (int vb = 0; vb < 8; ++vb) o[vb] = __builtin_amdgcn_mfma_f32_16x16x32_bf16(sf[ks][vb], qf[ks], o[vb], 0, 0, 0);
            float ss = 0.f;
#pragma unroll
            for (int vb = 0; vb < 8; ++vb) ss += (o[vb][0] * o[vb][0] + o[vb][1] * o[vb][1]) + (o[vb][2] * o[vb][2] + o[vb][3] * o[vb][3]);
            ss += __shfl_xor(ss, 16); ss += __shfl_xor(ss, 32);
            const float rstd = rsqrtf(ss * (1.0f / HD) + EPS);
            const size_t row = row0 + 16 * tb + fr;
            u32x2 gwv[8]; f32x4 ngv[8];
#pragma unroll
            for (int vb = 0; vb < 8; ++vb) { const int col = h * HD + 16 * vb + 4 * fq; gwv[vb] = *(const u32x2*)(PROJ + row * PROJW + 1536 + col); ngv[vb] = *(const f32x4*)(hg_norm_g + col); }
            __builtin_amdgcn_sched_barrier(0);
#pragma unroll
            for (int vb = 0; vb < 8; ++vb) {
                const int col = h * HD + 16 * vb + 4 * fq;
                const u32x2 gw = gwv[vb]; const f32x4 ng = ngv[vb];
                u32x2 w; w.x = pk2(o[vb][0] * rstd * ng.x * lo_bf(gw.x), o[vb][1] * rstd * ng.y * hi_bf(gw.x)); w.y = pk2(o[vb][2] * rstd * ng.z * lo_bf(gw.y), o[vb][3] * rstd * ng.w * hi_bf(gw.y));
                *(u32x2*)(HP + row * DM + col) = w;
            }
            __syncthreads();
        }
    }
    GRID_BAR_W();

    for (int rep_ = 0; rep_ < REP_P6; ++rep_) { PHASE_IDS();
    { pg8::DenseSched S; S.init(HP, WT_BR, NTOK, DM, DM, G, bid); pg8::EpiMix E{MM, GATE}; pg8::gemm_phase<1024>(L, S, E, wave0); }
    }
    GRID_BAR_W();

    for (int rep_ = 0; rep_ < REP_P7; ++rep_) { PHASE_IDS();
    { pg8::DenseSched S; S.init(MM, WT_OUT, NTOK, DM, DM, G, bid); pg8::EpiPlain E{MIX, DM}; pg8::gemm_phase<1024>(L, S, E, wave0); }
    }
    GRID_BAR_W();

    for (int rep_ = 0; rep_ < REP_P8; ++rep_) { PHASE_IDS();
        typedef short bf16x8 __attribute__((ext_vector_type(8)));
        const int fr = lane & 15, fq = lane >> 4;
        LAS unsigned char* HTH = L; LAS unsigned char* HTL = L + 33024;
        LAS float* PL = (LAS float*)(L + 66048);
        LAS float* LGT = (LAS float*)(L + 90624);
        LAS int* LE = (LAS int*)(L + 93184); LAS int* LR = LE + 128;
        bf16x8 wh[4][3], wl[4][3];
#pragma unroll
        for (int ks = 0; ks < 4; ++ks)
#pragma unroll
            for (int ct = 0; ct < 3; ++ct) {
                const int j = 16 * ct + fr; u32x4 hw, lw; unsigned hh[4], ll[4];
#pragma unroll
                for (int p = 0; p < 4; ++p) {
                    const int k = 128 * wave + 32 * ks + 8 * fq + 2 * p;
                    const float w0 = (j < 4) ? w_rg[k * 4 + j] : ((j < 36) ? w_re[k * 32 + j - 4] : 0.f), w1 = (j < 4) ? w_rg[(k + 1) * 4 + j] : ((j < 36) ? w_re[(k + 1) * 32 + j - 4] : 0.f);
                    const unsigned h0 = f2bf(w0), h1 = f2bf(w1); const unsigned l0 = f2bf(w0 - __uint_as_float(h0 << 16)), l1 = f2bf(w1 - __uint_as_float(h1 << 16));
                    hh[p] = h0 | (h1 << 16); ll[p] = l0 | (l1 << 16);
                }
                hw.x = hh[0]; hw.y = hh[1]; hw.z = hh[2]; hw.w = hh[3]; lw.x = ll[0]; lw.y = ll[1]; lw.z = ll[2]; lw.w = ll[3];
                wh[ks][ct] = __builtin_bit_cast(bf16x8, hw); wl[ks][ct] = __builtin_bit_cast(bf16x8, lw);
            }
        for (int rb = bid; rb < NTOK / 64; rb += G) {
            const int b = rb / 64; const float* ada = ADA + (size_t)b * 6144;
            f32x4 A1[4], A2[4], SH[4];
#pragma unroll
            for (int i = 0; i < 4; ++i) { const int e = i * 256 + lane * 4;
                A1[i] = *(const f32x4*)(g_post_mix + e) * *(const f32x4*)(ada + 2048 + e);
                A2[i] = *(const f32x4*)(g_pre_ffn + e) * (*(const f32x4*)(ada + 4096 + e) + 1.0f);
                SH[i] = *(const f32x4*)(ada + 3072 + e); }
            for (int grp = 0; grp < 4; ++grp) {
                f32x4 xin[2][4]; u32x2 min_[2][4];
#pragma unroll
                for (int i2 = 0; i2 < 2; ++i2) { const int r = rb * 64 + grp * 16 + 2 * wave + i2;
                    const f32x4* xr = (const f32x4*)(x + (size_t)r * DM) + lane; const u32x2* mr = (const u32x2*)(MIX + (size_t)r * DM) + lane;
#pragma unroll
                    for (int i = 0; i < 4; ++i) { xin[i2][i] = xr[64 * i]; min_[i2][i] = mr[64 * i]; } }
                __builtin_amdgcn_sched_barrier(0);
#pragma unroll
                for (int i2 = 0; i2 < 2; ++i2) {
                    const int rl = 2 * wave + i2, r = rb * 64 + grp * 16 + rl;
                    f32x4 hv[4], mx[4]; float ss = 0.f;
#pragma unroll
                    for (int i = 0; i < 4; ++i) { const u32x2 w = min_[i2][i]; mx[i] = (f32x4){lo_bf(w.x), hi_bf(w.x), lo_bf(w.y), hi_bf(w.y)}; hv[i] = xin[i2][i];
                        ss += (mx[i].x * mx[i].x + mx[i].y * mx[i].y) + (mx[i].z * mx[i].z + mx[i].w * mx[i].w); }
                    const float rstd1 = rsqrtf(wave_sum(ss) * (1.0f / DM) + EPS);
                    float s2 = 0.f;
#pragma unroll
                    for (int i = 0; i < 4; ++i) { const f32x4 h = hv[i] + A1[i] * (mx[i] * rstd1); hv[i] = h; s2 += (h.x * h.x + h.y * h.y) + (h.z * h.z + h.w * h.w);
                        *((f32x4*)(out + (size_t)r * DM) + lane + 64 * i) = h; }
                    const float rstd2 = rsqrtf(wave_sum(s2) * (1.0f / DM) + EPS);
                    u32x2* o = (u32x2*)(HN2 + (size_t)r * DM) + lane;
#pragma unroll
                    for (int i = 0; i < 4; ++i) { const f32x4 y = hv[i] * rstd2 * A2[i] + SH[i];
                        const unsigned h0 = f2bf(y.x), h1 = f2bf(y.y), h2 = f2bf(y.z), h3 = f2bf(y.w);
                        u32x2 wv; wv.x = h0 | (h1 << 16); wv.y = h2 | (h3 << 16); o[64 * i] = wv;
                        u32x2 lv; lv.x = pk2(y.x - __uint_as_float(h0 << 16), y.y - __uint_as_float(h1 << 16)); lv.y = pk2(y.z - __uint_as_float(h2 << 16), y.w - __uint_as_float(h3 << 16));
                        *(LAS u32x2*)(HTH + rl * 2064 + (i * 256 + lane * 4) * 2) = wv; *(LAS u32x2*)(HTL + rl * 2064 + (i * 256 + lane * 4) * 2) = lv; }
                }
                __syncthreads();
                f32x4 acc[3];
#pragma unroll
                for (int ct = 0; ct < 3; ++ct) acc[ct] = (f32x4){0.f, 0.f, 0.f, 0.f};
#pragma unroll
                for (int ks = 0; ks < 4; ++ks) {
                    const bf16x8 ah = *(const LAS bf16x8*)(HTH + fr * 2064 + (128 * wave + 32 * ks + 8 * fq) * 2), al = *(const LAS bf16x8*)(HTL + fr * 2064 + (128 * wave + 32 * ks + 8 * fq) * 2);
#pragma unroll
                    for (int ct = 0; ct < 3; ++ct) {
                        acc[ct] = __builtin_amdgcn_mfma_f32_16x16x32_bf16(ah, wh[ks][ct], acc[ct], 0, 0, 0);
                        acc[ct] = __builtin_amdgcn_mfma_f32_16x16x32_bf16(ah, wl[ks][ct], acc[ct], 0, 0, 0);
                        acc[ct] = __builtin_amdgcn_mfma_f32_16x16x32_bf16(al, wh[ks][ct], acc[ct], 0, 0, 0);
                    }
                }
#pragma unroll
                for (int ct = 0; ct < 3; ++ct)
#pragma unroll
                    for (int q = 0; q < 4; ++q) PL[(wave * 16 + 4 * fq + q) * 48 + 16 * ct + fr] = acc[ct][q];
                __syncthreads();
                for (int idx = tid; idx < 16 * 36; idx += NTHREADS) { const int row = idx / 36, col = idx % 36; float s = (col < 4) ? b_rg[col] : b_re[col - 4];
#pragma unroll
                    for (int w8 = 0; w8 < 8; ++w8) s += PL[(w8 * 16 + row) * 48 + col];
                    LGT[row * 40 + col] = s; }
                __syncthreads();
                if (tid < 16) {
                    const int rl = tid, r = rb * 64 + grp * 16 + rl; const LAS float* lg = LGT + rl * 40;
                    int gi = 0; float gm = lg[0];
#pragma unroll
                    for (int j = 1; j < 4; ++j) if (lg[j] > gm) { gm = lg[j]; gi = j; }
                    float den = 0.f;
#pragma unroll
                    for (int j = 0; j < 4; ++j) den += __expf(lg[j] - gm);
                    const float ptg = 1.0f / den;
                    int e1 = 0, e2 = 0; float l1 = -3.0e38f, l2 = -3.0e38f;
                    for (int j = 0; j < 8; ++j) { const float l = lg[4 + gi * 8 + j];
                        if (l > l1) { l2 = l1; e2 = e1; l1 = l; e1 = j; } else if (l > l2) { l2 = l; e2 = j; } }
                    const float w1 = 1.0f / (1.0f + __expf(l2 - l1));
                    TOK_E[r * 2] = gi * 8 + e1; TOK_E[r * 2 + 1] = gi * 8 + e2;
                    TOK_W[r * 2] = ptg * w1; TOK_W[r * 2 + 1] = ptg * (1.0f - w1);
                    LE[(grp * 16 + rl) * 2] = gi * 8 + e1; LE[(grp * 16 + rl) * 2 + 1] = gi * 8 + e2;
                }
            }
            __syncthreads();
            if (tid < NEXP) { int cnt = 0; for (int i = 0; i < 128; ++i) if (LE[i] == tid) { LR[i] = cnt; ++cnt; } WG_CNT[rb * NEXP + tid] = cnt; }
            __syncthreads();
            if (tid < 128) TOK_RANK[rb * 128 + tid] = LR[tid];
            __syncthreads();
        }
    }
    GRID_BAR_W();

    for (int rep_ = 0; rep_ < REP_P9; ++rep_) { PHASE_IDS();
    {
        LAS int* CN = (LAS int*)Lf;
        LAS int* PS = CN + 8192;
        LAS int* TOT = PS + 64;
        LAS int* PRE = PS + 128;
        for (int i = tid; i < (NTOK / 64) * NEXP; i += NTHREADS) CN[i] = WG_CNT[i];
        __syncthreads();
        for (int rb = bid; rb < NTOK / 64; rb += G) {
            if (tid < NEXP) { int run = 0, pre = 0;
#pragma unroll 8
                for (int q = 0; q < NTOK / 64; ++q) { if (q == rb) pre = run; run += CN[q * NEXP + tid]; } TOT[tid] = run; PRE[tid] = pre; }
            __syncthreads();
            if (tid == 0) { int s = 0; for (int e = 0; e < NEXP; ++e) { PS[e] = s; s += ((TOT[e] + 255) / 256) * 256; } PS[NEXP] = s; }
            __syncthreads();
            if (tid < 128) { const int aidx = rb * 128 + tid, e = TOK_E[aidx], pos = PS[e] + PRE[e] + TOK_RANK[aidx]; TOK_POS[aidx] = pos; ROW_TOK[pos] = aidx >> 1; }
            if (rb < NEXP) { const int e = rb; for (int p = PS[e] + TOT[e] + tid; p < PS[e + 1]; p += NTHREADS) ROW_TOK[p] = 0; }
            if (rb == 0 && tid <= NEXP) PSTART[tid] = PS[tid];
            __syncthreads();
        }
    }
    }
    GRID_BAR_DRAIN(NEXP * 64 * (64 / CONV_QK));

    for (int rep_ = 0; rep_ < REP_P10; ++rep_) { PHASE_IDS();
    { pg8::MoeSched<true> S; S.init(HN2, WE1, PSTART, ROW_TOK, 4, 1024, DM, G, bid, (LAS int*)(L + UT_OFF), tid); pg8::EpiGlu E{HMID}; pg8::gemm_phase<1024>(L, S, E, wave0); }
    }
    GRID_BAR_DRAIN(NEXP * CONV_TE * (64 / CONV_QK));

    for (int rep_ = 0; rep_ < REP_P11; ++rep_) { PHASE_IDS();
    { pg8::MoeSched<false> S; S.init(HMID, WE2, PSTART, ROW_TOK, 4, 1024, EFF, G, bid, (LAS int*)(L + UT_OFF), tid); pg8::EpiPlain E{YB, DM}; pg8::gemm_phase<512>(L, S, E, wave0); }
    }
    GRID_BAR();

    for (int rep_ = 0; rep_ < REP_P12; ++rep_) { PHASE_IDS();
    for (int r0 = (bid * NWAVES + wave) * 4; r0 < NTOK; r0 += G * NWAVES * 4) {
        const int b = r0 / SEQ; const float* ada = ADA + (size_t)b * 6144;
        int pp[4][2]; float ww[4][2];
#pragma unroll
        for (int q = 0; q < 4; ++q) { pp[q][0] = TOK_POS[(r0 + q) * 2]; pp[q][1] = TOK_POS[(r0 + q) * 2 + 1]; ww[q][0] = TOK_W[(r0 + q) * 2]; ww[q][1] = TOK_W[(r0 + q) * 2 + 1]; }
        u32x2 ya[4][2][4]; f32x4 hin[4][4];
#pragma unroll
        for (int q = 0; q < 4; ++q) {
#pragma unroll
            for (int kk = 0; kk < 2; ++kk) { const u32x2* yp = (const u32x2*)(YB + (size_t)pp[q][kk] * DM) + lane;
#pragma unroll
                for (int i = 0; i < 4; ++i) ya[q][kk][i] = yp[64 * i]; }
#pragma unroll
            for (int i = 0; i < 4; ++i) hin[q][i] = *((const f32x4*)(out + (size_t)(r0 + q) * DM) + lane + 64 * i);
        }
        f32x4 gpf[4], gt2[4];
#pragma unroll
        for (int i = 0; i < 4; ++i) { const int e = i * 256 + lane * 4; gpf[i] = *(const f32x4*)(g_post_ffn + e); gt2[i] = *(const f32x4*)(ada + 5120 + e); }
        __builtin_amdgcn_sched_barrier(0);
#pragma unroll
        for (int q = 0; q < 4; ++q) {
            const float w0 = ww[q][0], w1 = ww[q][1];
            f32x4 yv[4]; float ss = 0.f;
#pragma unroll
            for (int i = 0; i < 4; ++i) { const u32x2 a0 = ya[q][0][i], a1 = ya[q][1][i];
                f32x4 y; y.x = w0 * lo_bf(a0.x) + w1 * lo_bf(a1.x); y.y = w0 * hi_bf(a0.x) + w1 * hi_bf(a1.x); y.z = w0 * lo_bf(a0.y) + w1 * lo_bf(a1.y); y.w = w0 * hi_bf(a0.y) + w1 * hi_bf(a1.y);
                yv[i] = y; ss += (y.x * y.x + y.y * y.y) + (y.z * y.z + y.w * y.w); }
            const float rstd = rsqrtf(wave_sum(ss) * (1.0f / DM) + EPS);
#pragma unroll
            for (int i = 0; i < 4; ++i) *((f32x4*)(out + (size_t)(r0 + q) * DM) + lane + 64 * i) = hin[q][i] + gt2[i] * (yv[i] * rstd * gpf[i]);
        }
    }
    }
}

extern "C" void kernel_launch(void* const* d_in, const int* in_sizes, int n_in, void* d_out, int out_size, void* d_ws, size_t ws_size, hipStream_t stream) {
    static int grid = 0;
    if (grid == 0) {
        int dev = 0, cus = 0, per_cu = 0;
        if (n_in != 25 || out_size != NTOK * DM || ws_size < WS_END) { fprintf(stderr, "kernel_launch: unexpected problem (n_in %d out %d ws %zu)\n", n_in, out_size, ws_size); grid = -1; return; }
        if (hipGetDevice(&dev) != hipSuccess || hipDeviceGetAttribute(&cus, hipDeviceAttributeMultiprocessorCount, dev) != hipSuccess) { grid = -1; return; }
        if (hipFuncSetAttribute((const void*)mk_fwd, hipFuncAttributeMaxDynamicSharedMemorySize, LDS_BYTES) != hipSuccess) { fprintf(stderr, "hipFuncSetAttribute failed\n"); grid = -1; return; }
        if (hipOccupancyMaxActiveBlocksPerMultiprocessor(&per_cu, (const void*)mk_fwd, NTHREADS, LDS_BYTES) != hipSuccess || per_cu < 1) { fprintf(stderr, "occupancy query: %d\n", per_cu); }
        (void)hipGetLastError();
        grid = cus;
    }
    if (grid < 0) return;
    (void)hipMemsetAsync((char*)d_ws + WS_CTL, 0, CTL_BYTES, stream);
    Args a{};
    for (int i = 0; i < 25; ++i) a.in[i] = (const float*)d_in[i];
    a.out = (float*)d_out; a.ws = (unsigned char*)d_ws; a.ph_lo = 0; a.ph_hi = 100;
    hipLaunchKernelGGL(mk_fwd, dim3(grid), dim3(NTHREADS), LDS_BYTES, stream, a);
}
```

```cpp
#include <hip/hip_runtime.h>
#include <cstdio>
#include <cstdint>

#define LAS __attribute__((address_space(3)))
#define GAS __attribute__((address_space(1)))
#define DI __device__ __forceinline__

#define XB_TMO      128
#define XB_XCNT(j)  (256  + 64 * (j))
#define XB_XSUB(j)  (1280 + 64 * (j))
#define XB_XGEN(j)  (2304 + 64 * (j))
#define XB_TOP      3328
#define XB_TOPGEN   3392
#define XCD_BAR_WORDS 3456
#define XB_SPIN_CAP (1u << 18)

DI unsigned xb_ld(unsigned* p)              { return __hip_atomic_load(p, __ATOMIC_RELAXED, __HIP_MEMORY_SCOPE_AGENT); }
DI unsigned xb_add(unsigned* p, unsigned v) { return __hip_atomic_fetch_add(p, v, __ATOMIC_RELAXED, __HIP_MEMORY_SCOPE_AGENT); }
DI unsigned xb_xcc_id() { return (unsigned)__builtin_amdgcn_s_getreg((3 << 11) | 20) & 0xFu; }
#define XB_SPIN(cond, bar) do { unsigned _sp = 0; while (cond) { __builtin_amdgcn_s_sleep(1); \
    if ((++_sp & 255u) == 0u) { if (xb_ld(&(bar)[XB_TMO])) break; if (_sp > XB_SPIN_CAP) { atomicAdd(&(bar)[XB_TMO], 1u); break; } } } } while (0)

struct XcdBarrier { unsigned* bar; unsigned x; volatile LAS unsigned* st; };

DI XcdBarrier xcd_barrier_post(unsigned* bar, volatile LAS unsigned* st) {
    XcdBarrier b; b.bar = bar; b.x = xb_xcc_id(); b.st = st;
    if (threadIdx.x == 0) (void)xb_add(&bar[XB_XCNT(b.x)], 1u);
    return b;
}
DI void xcd_barrier_complete(unsigned* bar, unsigned x, unsigned& nloc, unsigned& nx) {
    const unsigned G = gridDim.x * gridDim.y * gridDim.z;
    unsigned sum, cnt, mine, sp = 0u;
    for (;;) {
        sum = 0u; cnt = 0u; mine = 0u;
#pragma unroll
        for (unsigned j = 0; j < 16; ++j) { const unsigned c = xb_ld(&bar[XB_XCNT(j)]); sum += c; cnt += (c > 0u) ? 1u : 0u; mine = (j == x) ? c : mine; }
        if (sum == G) break;
        __builtin_amdgcn_s_sleep(1);
        if ((++sp & 255u) == 0u) { if (xb_ld(&bar[XB_TMO])) break; if (sp > XB_SPIN_CAP) { atomicAdd(&bar[XB_TMO], 1u); break; } }
    }
    nloc = mine > 0u ? mine : 1u; nx = cnt > 0u ? cnt : 1u;
}
DI void xcd_barrier(const XcdBarrier& b) {
    asm volatile("s_waitcnt vmcnt(0)" ::: "memory");
    __syncthreads();
    if (threadIdx.x == 0) {
        unsigned* bar = b.bar;
        __builtin_amdgcn_s_waitcnt(0);
        unsigned nloc = b.st[0], nx = b.st[1];
        if (nloc == 0u) { xcd_barrier_complete(bar, b.x, nloc, nx); b.st[0] = nloc; b.st[1] = nx; }
        const unsigned old = xb_add(&bar[XB_XSUB(b.x)], 1u);
        const unsigned gen = old / nloc;
        if (old + 1u == (gen + 1u) * nloc) {
            __builtin_amdgcn_fence(__ATOMIC_RELEASE, "agent");
            asm volatile("s_waitcnt vmcnt(0)" ::: "memory");
            const unsigned og = xb_add(&bar[XB_TOP], 1u);
            const unsigned tg = og / nx;
            if (og + 1u == (tg + 1u) * nx) xb_add(&bar[XB_TOPGEN], 1u);
            else XB_SPIN(xb_ld(&bar[XB_TOPGEN]) == tg, bar);
            __builtin_amdgcn_fence(__ATOMIC_ACQUIRE, "agent");
            xb_add(&bar[XB_XGEN(b.x)], 1u);
            asm volatile("s_waitcnt vmcnt(0)" ::: "memory");
        } else {
            XB_SPIN(xb_ld(&bar[XB_XGEN(b.x)]) == gen, bar);
            __builtin_amdgcn_fence(__ATOMIC_ACQUIRE, "agent");
            asm volatile("s_waitcnt vmcnt(0)" ::: "memory");
        }
    }
    __syncthreads();
}


#ifndef REP_P0
#define REP_P0 1
#endif
#ifndef REP_P1
#define REP_P1 1
#endif
#ifndef REP_P2
#define REP_P2 1
#endif
#ifndef REP_P3
#define REP_P3 1
#endif
#ifndef REP_P4
#define REP_P4 1
#endif
#ifndef REP_P5
#define REP_P5 1
#endif
#ifndef REP_P6
#define REP_P6 1
#endif
#ifndef REP_P7
#define REP_P7 1
#endif
#ifndef REP_P8
#define REP_P8 1
#endif
#ifndef REP_P9
#define REP_P9 1
#endif
#ifndef REP_P10
#define REP_P10 1
#endif
#ifndef REP_P11
#define REP_P11 1
#endif
#ifndef REP_P12
#define REP_P12 1
#endif

constexpr int NTHREADS = 512, NWAVES = 8;
constexpr int NB = 4, SEQ = 4096, NTOK = NB * SEQ, DM = 1024;
constexpr int HGW = 512, NHEAD = 4, HD = 128, CHUNK = 64, NCHUNK = SEQ / CHUNK;
constexpr int PROJW = 2560, GATEW = 2048, NPG = PROJW + GATEW;
constexpr int NEXP = 32, EFF = 512, PMAX = 40960;
constexpr float EPS = 1e-6f;

constexpr size_t MiB = 1u << 20;
constexpr size_t WS_CTL = 0, CTL_BYTES = 1 * MiB;
constexpr size_t WS_ADAP = 1 * MiB;
constexpr size_t WS_ADA = 2 * MiB;
constexpr size_t WS_ROUT = 3 * MiB;
constexpr size_t WS_TOK_E = WS_ROUT, WS_TOK_W = WS_ROUT + 128 * 1024, WS_TOK_RANK = WS_ROUT + 256 * 1024, WS_TOK_POS = WS_ROUT + 384 * 1024,
                 WS_WG_CNT = WS_ROUT + 512 * 1024, WS_PSTART = WS_ROUT + 544 * 1024, WS_ROW_TOK = WS_ROUT + 576 * 1024;
constexpr size_t WS_DEC = 4 * MiB;
constexpr size_t WS_OML = 5 * MiB;
constexpr size_t WS_WT_IN = 8 * MiB, WS_WT_BR = 17 * MiB, WS_WT_OUT = 19 * MiB;
constexpr size_t WS_WE1 = 24 * MiB, WS_WE2 = 88 * MiB;
constexpr size_t WS_A1 = 120 * MiB;
constexpr size_t WS_A2 = 200 * MiB;
constexpr size_t WS_A3 = 264 * MiB;
constexpr size_t WS_END = 296 * MiB;
constexpr int CW_BAR = 4096, CW_WORK = 8256;

constexpr int LDS_BYTES = 160 * 1024 - 512;
constexpr int MISC_OFF = LDS_BYTES - 256, PTAB_OFF = LDS_BYTES - 512, UT_OFF = LDS_BYTES - 1024;

typedef unsigned short bf16;
typedef float f32x4 __attribute__((ext_vector_type(4)));
typedef unsigned u32x2 __attribute__((ext_vector_type(2)));
typedef unsigned u32x4 __attribute__((ext_vector_type(4)));

DI float bf2f(bf16 b) { return __uint_as_float(((unsigned)b) << 16); }
typedef float f32x2_ __attribute__((ext_vector_type(2)));
typedef __bf16 bf16x2_ __attribute__((ext_vector_type(2)));
DI unsigned pk2(float lo, float hi) { const f32x2_ v = {lo, hi}; return __builtin_bit_cast(unsigned, __builtin_convertvector(v, bf16x2_)); }
DI unsigned f2bf(float f) { return pk2(f, 0.f) & 0xffffu; }
DI float lo_bf(unsigned w) { return __uint_as_float(w << 16); }
DI float hi_bf(unsigned w) { return __uint_as_float(w & 0xffff0000u); }
DI float wave_sum(float v) {
#pragma unroll
    for (int o = 1; o < 64; o <<= 1) v += __shfl_xor(v, o);
    return v;
}
DI float sigm(float x) { return __builtin_amdgcn_rcpf(1.0f + __expf(-x)); }
DI float silu(float x) { return x * sigm(x); }

DI int lane_id_opaque() { int l = (int)__builtin_amdgcn_mbcnt_hi(~0u, __builtin_amdgcn_mbcnt_lo(~0u, 0u)); asm volatile("" : "+v"(l)); return l; }

DI const void* ldp(LAS const unsigned long long* pt, int i) { const unsigned long long v = pt[i]; const unsigned lo = __builtin_amdgcn_readfirstlane((unsigned)v), hi = __builtin_amdgcn_readfirstlane((unsigned)(v >> 32)); return (const void*)(const GAS void*)(((unsigned long long)hi << 32) | lo); }

struct Args { const float* in[25]; float* out; unsigned char* ws; int ph_lo, ph_hi; };

namespace pg8 {
typedef short bf16x8 __attribute__((ext_vector_type(8)));
constexpr int BM = 256, BK = 64, HALF = 128, HTB = HALF * BK * 2, STAGE_BYTES = 8 * HTB, NXCD = 8, WGM = 8;
DI int lds_byte(int r, int c) { const int st = (r >> 4) * 2 + (c >> 5), rr = r & 15, cc = c & 31, ob = rr * 64 + cc * 2; return st * 1024 + (ob ^ (((ob >> 9) & 1) << 5)); }
DI void stage_rc(int b, int& R, int& C) { const int st = b / 1024, sb = b % 1024, swz = sb ^ (((sb >> 9) & 1) << 5); R = (st >> 1) * 16 + swz / 64; C = (st & 1) * 32 + (swz % 64) / 2; }
DI int perm32(int rho) { const int n = rho >> 4, i = rho & 15; return 8 * (i >> 2) + 4 * n + (i & 3); }
DI unsigned cvt_pk_bf16(float lo, float hi) { return pk2(lo, hi); }

struct Unit { const char* B; int pm, pn, e, row0, half; };
DI int xcd_remap(int wgid, int nwg) { const int q = nwg / NXCD, r = nwg % NXCD, xcd = wgid % NXCD, off = wgid / NXCD; return (xcd < r ? xcd * (q + 1) : r * (q + 1) + (xcd - r) * q) + off; }

struct DenseSched {
    const char* A; const char* Bt; int nM, nN, nwg, G, c, K;
    DI void init(const void* A_, const void* Bt_, int M, int N, int K_, int G_, int c_) { A = (const char*)A_; Bt = (const char*)Bt_; nM = M / BM; nN = N / BM; nwg = nM * nN; G = G_; c = c_; K = K_; }
    DI bool next(int i, Unit& u) const {
        const int L = i * G + c, nfull = (nwg / G) * G;
        int wgid, half = 0, hs = 0;
        if (L < nfull) wgid = xcd_remap(L, nfull);
        else { const int h = L - nfull; if (h >= 2 * (nwg - nfull)) return false; wgid = nfull + (h >> 1); half = 1; hs = h & 1; }
        const int nig = WGM * nN, gid = wgid / nig, fm = gid * WGM, gsz = (nM - fm) < WGM ? (nM - fm) : WGM;
        u.pm = fm + ((wgid % nig) % gsz); u.pn = (wgid % nig) / gsz; u.e = 0; u.B = Bt + (size_t)u.pn * BM * K * 2; u.half = half; u.row0 = u.pm * BM + hs * HALF; return true;
    }
    DI const char* abase() const { return A; }
    DI unsigned arow(const Unit& u, int r) const { return (unsigned)(u.row0 + (u.half ? (r & (HALF - 1)) : r)); }
};
template <bool GATHER> struct MoeSched {
    const char* A; const char* WT; const int* row_tok; LAS const int* ut; int K, nrows;
    DI void init(const void* A_, const void* WT_, const int* pstart_g, const int* row_tok_, int nN, int nrows_, int K_, int G, int c, LAS int* ut_, int tid) {
        const int* pstart = pstart_g;
        A = (const char*)A_; WT = (const char*)WT_; row_tok = row_tok_; nrows = nrows_; K = K_; ut = ut_;
        if (tid <= NEXP) ut_[92 + tid] = pstart[tid];
        __syncthreads();
        if (tid == 0) {
            LAS const int* pstart = ut_ + 92;
            const int nwg = (pstart[NEXP] / BM) * nN, nfull = (nwg / G) * G;
            for (int i = 0; i < 23; ++i) {
                const int L = i * G + c; int pm = -1, pn = 0, e = 0, hf = 0;
                int wgid = -1;
                if (L < nfull) wgid = xcd_remap(L, nfull);
                else { const int h = L - nfull; if (h < 2 * (nwg - nfull)) { wgid = nfull + (h >> 1); hf = 1 + (h & 1); } }
                if (wgid >= 0) { pm = wgid / nN; pn = wgid % nN; for (int q = 1; q < NEXP; ++q) if (pm * BM >= pstart[q]) e = q; }
                ut_[i * 4] = pm; ut_[i * 4 + 1] = pn; ut_[i * 4 + 2] = e; ut_[i * 4 + 3] = hf;
                if (pm < 0) break;
            }
        }
        __syncthreads();
    }
    DI bool next(int i, Unit& u) const {
        const int pm = __builtin_amdgcn_readfirstlane(ut[i * 4]); if (pm < 0) return false;
        u.pm = pm; u.pn = __builtin_amdgcn_readfirstlane(ut[i * 4 + 1]); u.e = __builtin_amdgcn_readfirstlane(ut[i * 4 + 2]);
        const int hf = __builtin_amdgcn_readfirstlane(ut[i * 4 + 3]); u.half = hf ? 1 : 0; u.row0 = pm * BM + (hf == 2 ? HALF : 0);
        u.B = WT + ((size_t)u.e * nrows + (size_t)u.pn * BM) * K * 2; return true;
    }
    DI const char* abase() const { return A; }
    DI unsigned arow(const Unit& u, int r) const { const int rr = u.row0 + (u.half ? (r & (HALF - 1)) : r); return GATHER ? (unsigned)row_tok[rr] : (unsigned)rr; }
};

template <int K, class Epi, class Sched>
DI void gemm_phase(LAS unsigned char* lds, const Sched& S, const Epi& E, int wave_sgpr) {
    const int lane = lane_id_opaque(), wid = wave_sgpr, tid = wid * 64 + lane, wr = wid >> 2, wc = wid & 3, fr = lane & 15, fq = lane >> 4;
    constexpr int nt = K / BK;
    unsigned voffB[2];
#pragma unroll
    for (int i = 0; i < 2; ++i) { int R, C; stage_rc(tid * 16 + i * 8192, R, C); const int Rb = Epi::PERM ? ((R & ~31) + perm32(R & 31)) : R; voffB[i] = (unsigned)(Rb * K + C) * 2u; }
#define PG8_RC(i, R, C) int R, C; stage_rc((wid * 64 + lane_id_opaque()) * 16 + (i) * 8192, R, C)
    constexpr size_t kstep = (size_t)(BK * 2);
    constexpr size_t hstep = (size_t)HALF * K * 2;
    const unsigned ldsw = (unsigned)wid * 1024u;
    const int aoff = lds_byte(wr * 64 + fr, fq * 8), boff = lds_byte(wc * 32 + fr, fq * 8);
#define PG8_SA(b, h) (((b) * 2 + (h)) * HTB)
#define PG8_SB(b, h) ((4 + (b) * 2 + (h)) * HTB)
#define PG8_STAGE(bufoff, gbase, voff) do { _Pragma("unroll") for (int _i = 0; _i < 2; ++_i) \
        __builtin_amdgcn_global_load_lds((const unsigned*)((const char*)(gbase) + (voff)[_i]), (LAS unsigned*)(lds + (bufoff) + ldsw + _i * 8192), 16, 0, 0); } while (0)
#define PG8_LDA(dst, b, h) do { _Pragma("unroll") for (int m = 0; m < 4; ++m) _Pragma("unroll") for (int k = 0; k < 2; ++k) dst[m][k] = *(const LAS bf16x8*)(lds + PG8_SA(b, h) + aoff + m * 2048 + k * 1024); } while (0)
#define PG8_LDB(dst, b, h) do { _Pragma("unroll") for (int n = 0; n < 2; ++n) _Pragma("unroll") for (int k = 0; k < 2; ++k) dst[n][k] = *(const LAS bf16x8*)(lds + PG8_SB(b, h) + boff + n * 2048 + k * 1024); } while (0)
#define PG8_MMA(ai, bj, At, Bt) do { __builtin_amdgcn_s_setprio(1); _Pragma("unroll") for (int m = 0; m < 4; ++m) _Pragma("unroll") for (int n = 0; n < 2; ++n) _Pragma("unroll") for (int k = 0; k < 2; ++k) \
        acc[ai][bj][m][n] = __builtin_amdgcn_mfma_f32_16x16x32_bf16(Bt[n][k], At[m][k], acc[ai][bj][m][n], 0, 0, 0); __builtin_amdgcn_s_setprio(0); } while (0)
#define PG8_WAIT_V(n) asm volatile("s_waitcnt vmcnt(" #n ")" ::: "memory")
#define PG8_WAIT_L(n) asm volatile("s_waitcnt lgkmcnt(" #n ")" ::: "memory")
#define PG8_BAR __builtin_amdgcn_s_barrier()
#define PG8_SCHED __builtin_amdgcn_sched_barrier(0)
    Unit cur, nxt; int ui = 0;
    if (!S.next(0, cur)) return;
    f32x4 acc[2][2][4][2];
#pragma unroll
    for (int a = 0; a < 2; ++a)
#pragma unroll
        for (int b = 0; b < 2; ++b)
#pragma unroll
            for (int m = 0; m < 4; ++m)
#pragma unroll
                for (int n = 0; n < 2; ++n) acc[a][b][m][n] = (f32x4){0.f, 0.f, 0.f, 0.f};
    bf16x8 At[4][2], B0[2][2], B1[2][2];
    unsigned cv0[2], cv1[2], nv0[2], nv1[2];
#pragma unroll
    for (int i = 0; i < 2; ++i) { PG8_RC(i, R_, C_); cv0[i] = (S.arow(cur, R_) * (unsigned)K + (unsigned)C_) * 2u; cv1[i] = (S.arow(cur, HALF + R_) * (unsigned)K + (unsigned)C_) * 2u; }
    const char* const cA = S.abase(); const char* cB = cur.B;
    PG8_STAGE(PG8_SB(0, 0), cB, voffB); PG8_STAGE(PG8_SB(0, 1), cB + hstep, voffB); PG8_STAGE(PG8_SA(0, 0), cA, cv0); PG8_STAGE(PG8_SA(0, 1), cA, cv1);
    if (wr == 1) PG8_BAR;
    PG8_WAIT_V(2); PG8_BAR;
    PG8_STAGE(PG8_SB(1, 0), cB + kstep, voffB); PG8_STAGE(PG8_SA(1, 0), cA + kstep, cv0); PG8_STAGE(PG8_SB(1, 1), cB + hstep + kstep, voffB);
    PG8_WAIT_V(6); PG8_BAR;
    for (;;) {
        const bool has_next = S.next(ui + 1, nxt);
        const char* nB = has_next ? nxt.B : cB;
#pragma unroll
        for (int i = 0; i < 2; ++i) { PG8_RC(i, R_, C_); nv0[i] = has_next ? (S.arow(nxt, R_) * (unsigned)K + (unsigned)C_) * 2u : cv0[i]; nv1[i] = has_next ? (S.arow(nxt, HALF + R_) * (unsigned)K + (unsigned)C_) * 2u : cv1[i]; }
        for (int t = 0; t < nt; t += 2) {
            const bool last = (t == nt - 2);
            if constexpr (Epi::MID) { if (t == nt / 2) E.mid(acc, cur, wr, wc, fr, fq); }
            const char* a1 = cA + (size_t)(t + 1) * kstep;
            const char* a2 = last ? cA : cA + (size_t)(t + 2) * kstep; const char* b2 = last ? nB : cB + (size_t)(t + 2) * kstep;
            const char* a3 = a2 + kstep; const char* b3 = b2 + kstep;
            unsigned s0[2], s1[2];
#pragma unroll
            for (int i = 0; i < 2; ++i) { s0[i] = last ? nv0[i] : cv0[i]; s1[i] = last ? nv1[i] : cv1[i]; }
            PG8_LDB(B0, 0, 0); PG8_LDB(B1, 0, 1); PG8_SCHED; PG8_LDA(At, 0, 0); PG8_STAGE(PG8_SA(1, 1), a1, cv1);
            PG8_WAIT_V(8); PG8_WAIT_L(0); PG8_BAR; PG8_MMA(0, 0, At, B0); PG8_MMA(0, 1, At, B1); PG8_BAR; PG8_SCHED;
            PG8_LDA(At, 0, 1); PG8_STAGE(PG8_SB(0, 0), b2, voffB); PG8_STAGE(PG8_SB(0, 1), b2 + hstep, voffB); PG8_STAGE(PG8_SA(0, 0), a2, s0);
            PG8_WAIT_V(8); PG8_WAIT_L(0); PG8_BAR; if (!cur.half) { PG8_MMA(1, 0, At, B0); PG8_MMA(1, 1, At, B1); } PG8_BAR; PG8_SCHED;
            PG8_LDB(B0, 1, 0); PG8_LDB(B1, 1, 1); PG8_SCHED; PG8_LDA(At, 1, 0); PG8_STAGE(PG8_SA(0, 1), a2, s1);
            PG8_WAIT_V(8); PG8_WAIT_L(0); PG8_BAR; PG8_MMA(0, 0, At, B0); PG8_MMA(0, 1, At, B1); PG8_BAR; PG8_SCHED;
            PG8_LDA(At, 1, 1); PG8_STAGE(PG8_SB(1, 0), b3, voffB); PG8_STAGE(PG8_SB(1, 1), b3 + hstep, voffB); PG8_STAGE(PG8_SA(1, 0), a3, s0);
            PG8_WAIT_V(8); PG8_WAIT_L(0); PG8_BAR; if (!cur.half) { PG8_MMA(1, 0, At, B0); PG8_MMA(1, 1, At, B1); } PG8_BAR; PG8_SCHED;
        }
        if (wr == 0) PG8_BAR;
        E(acc, cur, wr, wc, fr, fq);
        if (!has_next) break;
#pragma unroll
        for (int a = 0; a < 2; ++a)
#pragma unroll
            for (int b = 0; b < 2; ++b)
#pragma unroll
                for (int m = 0; m < 4; ++m)
#pragma unroll
                    for (int n = 0; n < 2; ++n) acc[a][b][m][n] = (f32x4){0.f, 0.f, 0.f, 0.f};
        cur = nxt; cB = nB; ++ui;
#pragma unroll
        for (int i = 0; i < 2; ++i) { cv0[i] = nv0[i]; cv1[i] = nv1[i]; }
        if (wr == 1) PG8_BAR;
    }
    PG8_WAIT_V(0);
    PG8_BAR;
#undef PG8_RC
#undef PG8_SA
#undef PG8_SB
#undef PG8_STAGE
#undef PG8_LDA
#undef PG8_LDB
#undef PG8_MMA
#undef PG8_WAIT_V
#undef PG8_WAIT_L
#undef PG8_BAR
#undef PG8_SCHED
}

typedef f32x4 Acc[2][2][4][2];
DI u32x4 pack8(const f32x4& v0, const f32x4& v1) { u32x4 w; w.x = cvt_pk_bf16(v0[0], v0[1]); w.y = cvt_pk_bf16(v0[2], v0[3]); w.z = cvt_pk_bf16(v1[0], v1[1]); w.w = cvt_pk_bf16(v1[2], v1[3]); return w; }

struct EpiPlain {
    static constexpr bool PERM = true, MID = false;
    bf16* O; int ldc;
    DI void operator()(const Acc& acc, const Unit& u, int wr, int wc, int fr, int fq) const {
        int row0 = u.row0 + wr * 64 + fr, col0 = u.pn * BM + wc * 32 + 8 * fq; const int half = u.half;
        asm volatile("" : "+v"(row0));
#pragma unroll
        for (int ai = 0; ai < 2; ++ai) { if (ai == 1 && half) break;
#pragma unroll
            for (int m = 0; m < 4; ++m) { bf16* rowp = O + (size_t)(row0 + ai * HALF + m * 16) * ldc + col0;
#pragma unroll
                for (int bj = 0; bj < 2; ++bj) *(u32x4*)(rowp + bj * HALF) = pack8(acc[ai][bj][m][0], acc[ai][bj][m][1]); } }
    }
};
struct EpiProj {
    static constexpr bool PERM = true, MID = false;
    bf16* P; bf16* Gt; const float* oml; const float* b_gate;
    template <int TYPE> DI void run(const Acc& acc, bf16* base, int ldc, int row0, int col0, const float* cvp, int half) const {
        f32x4 cv[2][2];
#pragma unroll
        for (int bj = 0; bj < 2; ++bj)
#pragma unroll
            for (int n = 0; n < 2; ++n) cv[bj][n] = (TYPE == 1 || TYPE == 3) ? *(const f32x4*)(cvp + bj * HALF + 4 * n) : (f32x4){0.f, 0.f, 0.f, 0.f};
#pragma unroll
        for (int ai = 0; ai < 2; ++ai) { if (ai == 1 && half) break;
#pragma unroll
            for (int m = 0; m < 4; ++m) { bf16* rowp = base + (size_t)(row0 + ai * HALF + m * 16) * ldc + col0;
#pragma unroll
                for (int bj = 0; bj < 2; ++bj) { f32x4 v[2] = {acc[ai][bj][m][0], acc[ai][bj][m][1]};
#pragma unroll
                    for (int n = 0; n < 2; ++n)
#pragma unroll
                        for (int j = 0; j < 4; ++j) { const float t = v[n][j];
                            if (TYPE == 0) v[n][j] = silu(t); else if (TYPE == 1) v[n][j] = cv[bj][n][j] * sigm(-t); else if (TYPE == 3) v[n][j] = sigm(t + cv[bj][n][j]); }
                    *(u32x4*)(rowp + bj * HALF) = pack8(v[0], v[1]); } } }
    }
    DI void gates(const Acc& acc, const Unit& u, int wr, int wc, int fr, int fq) const {
        const int p = u.pn - 10, ch0 = p * HALF + wc * 32 + 8 * fq, wave = wr * 4 + wc, lane = fq * 16 + fr, ai0 = (u.row0 - u.pm * BM) >> 7;
        f32x4 b1[2], b2[2];
#pragma unroll
        for (int n = 0; n < 2; ++n) { b1[n] = *(const f32x4*)(b_gate + ch0 + 4 * n); b2[n] = *(const f32x4*)(b_gate + 1024 + ch0 + 4 * n); }
        size_t base = ((size_t)(u.pm * 8 + p) * 8 + wave) * 8 * 64 + lane;
        asm volatile("" : "+v"(base));
#pragma unroll
        for (int ai = 0; ai < 2; ++ai) { if (ai == 1 && u.half) break;
#pragma unroll
            for (int m = 0; m < 4; ++m) { f32x4 r[2], g[2];
#pragma unroll
                for (int n = 0; n < 2; ++n)
#pragma unroll
                    for (int j = 0; j < 4; ++j) { const float g1 = sigm(acc[ai][0][m][n][j] + b1[n][j]), g2 = fmaxf(sigm(acc[ai][1][m][n][j] + b2[n][j]), 1e-30f); g[n][j] = g2; r[n][j] = g1 * __builtin_amdgcn_rcpf(g2); }
                const size_t idx = base + (size_t)((ai0 + ai) * 4 + m) * 64;
                *((u32x4*)Gt + idx) = pack8(r[0], r[1]); *((u32x4*)Gt + (size_t)NTOK * DM / 8 + idx) = pack8(g[0], g[1]); } }
    }
    DI void operator()(const Acc& acc, const Unit& u, int wr, int wc, int fr, int fq) const {
        if (u.pn >= 10) { gates(acc, u, wr, wc, fr, fq); return; }
        int row0 = u.row0 + wr * 64 + fr; const int colt = u.pn * BM + wc * 32 + 8 * fq;
        asm volatile("" : "+v"(row0));
        if (u.pn < 2 || (u.pn >= 6 && u.pn < 8)) run<0>(acc, P, PROJW, row0, colt, nullptr, u.half);
        else if (u.pn < 4) run<1>(acc, P, PROJW, row0, colt, oml + (colt - 512), u.half);
        else run<2>(acc, P, PROJW, row0, colt, nullptr, u.half);
    }
};
struct EpiMix {
    static constexpr bool PERM = true, MID = true;
    bf16* O; const bf16* Gt;
    DI void mid(Acc& acc, const Unit& u, int wr, int wc, int fr, int fq) const {
        size_t base = ((size_t)(u.pm * 8 + 2 * u.pn) * 8 + (wr * 4 + wc)) * 8 * 64 + (fq * 16 + fr);
        asm volatile("" : "+v"(base));
        const u32x4* gp = (const u32x4*)Gt + base;
#pragma unroll
        for (int ai = 0; ai < 2; ++ai) {
            u32x4 rw[4][2];
#pragma unroll
            for (int m = 0; m < 4; ++m)
#pragma unroll
                for (int bj = 0; bj < 2; ++bj) rw[m][bj] = gp[(size_t)bj * 8 * 8 * 64 + (size_t)(ai * 4 + m) * 64];
            asm volatile("" : "+v"(rw[0][0]), "+v"(rw[0][1]), "+v"(rw[1][0]), "+v"(rw[1][1]), "+v"(rw[2][0]), "+v"(rw[2][1]), "+v"(rw[3][0]), "+v"(rw[3][1]));
#pragma unroll
            for (int m = 0; m < 4; ++m)
#pragma unroll
                for (int bj = 0; bj < 2; ++bj) { const unsigned w[4] = {rw[m][bj].x, rw[m][bj].y, rw[m][bj].z, rw[m][bj].w};
#pragma unroll
                    for (int n = 0; n < 2; ++n)
#pragma unroll
                        for (int j = 0; j < 4; ++j) { const unsigned a = w[n * 2 + (j >> 1)]; acc[ai][bj][m][n][j] *= (j & 1) ? hi_bf(a) : lo_bf(a); } }
        }
    }
    DI void operator()(const Acc& acc, const Unit& u, int wr, int wc, int fr, int fq) const {
        int row0 = u.row0 + wr * 64 + fr, col0 = u.pn * BM + wc * 32 + 8 * fq;
        size_t base = (size_t)NTOK * DM / 8 + ((size_t)(u.pm * 8 + 2 * u.pn) * 8 + (wr * 4 + wc)) * 8 * 64 + (fq * 16 + fr);
        asm volatile("" : "+v"(row0), "+v"(base));
        const u32x4* gp = (const u32x4*)Gt + base;
#pragma unroll
        for (int ai = 0; ai < 2; ++ai) {
            u32x4 gw[4][2];
#pragma unroll
            for (int m = 0; m < 4; ++m)
#pragma unroll
                for (int bj = 0; bj < 2; ++bj) gw[m][bj] = gp[(size_t)bj * 8 * 8 * 64 + (size_t)(ai * 4 + m) * 64];
            asm volatile("" : "+v"(gw[0][0]), "+v"(gw[0][1]), "+v"(gw[1][0]), "+v"(gw[1][1]), "+v"(gw[2][0]), "+v"(gw[2][1]), "+v"(gw[3][0]), "+v"(gw[3][1]));
#pragma unroll
            for (int m = 0; m < 4; ++m) { bf16* rowp = O + (size_t)(row0 + ai * HALF + m * 16) * DM + col0;
#pragma unroll
                for (int bj = 0; bj < 2; ++bj) { const unsigned w[4] = {gw[m][bj].x, gw[m][bj].y, gw[m][bj].z, gw[m][bj].w};
                    f32x4 v[2];
#pragma unroll
                    for (int n = 0; n < 2; ++n)
#pragma unroll
                        for (int j = 0; j < 4; ++j) { const unsigned b = w[n * 2 + (j >> 1)]; v[n][j] = acc[ai][bj][m][n][j] * ((j & 1) ? hi_bf(b) : lo_bf(b)); }
                    *(u32x4*)(rowp + bj * HALF) = pack8(v[0], v[1]); } }
        }
    }
};
struct EpiGlu {
    static constexpr bool PERM = true, MID = false;
    bf16* O;
    DI void operator()(const Acc& acc, const Unit& u, int wr, int wc, int fr, int fq) const {
        int row0 = u.row0 + wr * 64 + fr, col0 = u.pn * HALF + wc * 32 + 8 * fq; const int half = u.half;
        asm volatile("" : "+v"(row0));
#pragma unroll
        for (int ai = 0; ai < 2; ++ai) { if (ai == 1 && half) break;
#pragma unroll
            for (int m = 0; m < 4; ++m) { f32x4 v[2];
#pragma unroll
                for (int n = 0; n < 2; ++n)
#pragma unroll
                    for (int j = 0; j < 4; ++j) v[n][j] = silu(acc[ai][0][m][n][j]) * acc[ai][1][m][n][j];
                *(u32x4*)(O + (size_t)(row0 + ai * HALF + m * 16) * EFF + col0) = pack8(v[0], v[1]); } }
    }
};
}

#ifndef CONV_QK
#define CONV_QK 32
#endif
struct ConvPtrs { const float *w_in, *w_gate, *w_bhg, *w_out, *w_eg, *w_eu, *w_ed; bf16 *WT_IN, *WT_BR, *WT_OUT, *WE1, *WE2; };
constexpr int CONV_T_IN = 16 * 10, CONV_T_GATE = 16 * 8, CONV_T_BHG = 8 * 4, CONV_T_OUT = 16 * 4, CONV_T0 = CONV_T_IN + CONV_T_GATE + CONV_T_BHG + CONV_T_OUT, CONV_TE = 96, CONV_NTILES = CONV_T0 + NEXP * CONV_TE;
DI void conv_decode(const ConvPtrs& p, int it, const float*& srcp, int& N, bf16*& dstp, int& ldk, int& glu) {
    int r = it; glu = 0;
    if (r < CONV_T_IN) { const int kb = r / 10, nb = r % 10; N = PROJW; srcp = p.w_in + (size_t)kb * 64 * PROJW + nb * 256; dstp = p.WT_IN + (size_t)(nb * 256) * DM + kb * 64; ldk = DM; return; } r -= CONV_T_IN;
    if (r < CONV_T_GATE) { const int kb = r / 8, nb = r % 8; N = GATEW; srcp = p.w_gate + (size_t)kb * 64 * GATEW + nb * 256; dstp = p.WT_IN + (size_t)(PROJW + 512 * (nb & 3) + 128 * (nb >> 2)) * DM + kb * 64; ldk = DM; glu = 1; return; } r -= CONV_T_GATE;
    if (r < CONV_T_BHG) { const int kb = r / 4, nb = r % 4; N = DM; srcp = p.w_bhg + (size_t)kb * 64 * DM + nb * 256; dstp = p.WT_BR + (size_t)(nb * 256) * DM + kb * 64; ldk = DM; return; } r -= CONV_T_BHG;
    if (r < CONV_T_OUT) { const int kb = r / 4, nb = r % 4; N = DM; srcp = p.w_out + (size_t)kb * 64 * DM + nb * 256; dstp = p.WT_OUT + (size_t)(nb * 256) * DM + kb * 64; ldk = DM; return; } r -= CONV_T_OUT;
    const int e = r / CONV_TE; r %= CONV_TE;
    if (r < 64) { const int up = r >> 5, q = r & 31, kb = q >> 1, nb = q & 1; N = EFF; srcp = (up ? p.w_eu : p.w_eg) + (size_t)e * DM * EFF + (size_t)kb * 64 * EFF + nb * 256;
        dstp = p.WE1 + ((size_t)e * 1024 + nb * 512 + up * 128) * DM + kb * 64; ldk = DM; glu = 1; return; }
    { const int q = r - 64, kb = q >> 2, nb = q & 3; N = DM; srcp = p.w_ed + (size_t)e * EFF * DM + (size_t)kb * 64 * DM + nb * 256; dstp = p.WE2 + ((size_t)e * 1024 + nb * 256) * EFF + kb * 64; ldk = EFF; }
}
#define P0_ISSUE(PRE, IT, THI, DST, LDK, GLU) do { if ((IT) < (THI)) { const float* srcp_; int N_; conv_decode(p, (IT), srcp_, N_, DST, LDK, GLU); \
        _Pragma("unroll") for (int i = 0; i < 8; ++i) PRE[i] = *(const f32x4*)(srcp_ + (size_t)((tid >> 6) + 8 * i) * N_ + (tid & 63) * 4); } } while (0)
#define P0_STAGE(PRE, TLB) do { _Pragma("unroll") for (int i = 0; i < 8; ++i) { const int k = (tid >> 6) + 8 * i; *(LAS f32x4*)((TLB) + k * 256 + ((((tid & 63) ^ (k >> 3)) & 63) << 2)) = PRE[i]; } } while (0)
#define P0_EMIT(TLB, CD, CL, CG) do { const int c = tid & 7; _Pragma("unroll") for (int q = 0; q < 4; ++q) { const int n = (tid >> 3) + 64 * q; const int drow = (CG) ? ((n >> 7) * 256 + (n & 127)) : n; \
        const LAS float* s = (TLB) + (8 * c) * 256 + ((((n >> 2) ^ c) & 63) << 2) + (n & 3); \
        u32x4 o; o.x = pk2(s[0], s[256]); o.y = pk2(s[2 * 256], s[3 * 256]); o.z = pk2(s[4 * 256], s[5 * 256]); o.w = pk2(s[6 * 256], s[7 * 256]); \
        *(u32x4*)((CD) + (size_t)drow * (CL) + 8 * c) = o; } } while (0)
DI void convert_tiles(const ConvPtrs& p, LAS float* TL, int tid, int t_lo, int t_hi, int worker, int nworkers) {
    f32x4 pa[8], pb[8]; bf16* da = nullptr; bf16* db = nullptr; int la = 0, lb = 0, ga = 0, gb = 0;
    int it = t_lo + worker;
    P0_ISSUE(pa, it, t_hi, da, la, ga); P0_ISSUE(pb, it + nworkers, t_hi, db, lb, gb);
    LAS float* TL1 = TL + 64 * 256;
    while (it < t_hi) {
        { P0_STAGE(pa, TL); bf16* cd = da; const int cl = la, cg = ga; P0_ISSUE(pa, it + 2 * nworkers, t_hi, da, la, ga); __syncthreads(); P0_EMIT(TL, cd, cl, cg); }
        it += nworkers; if (it >= t_hi) break;
        { P0_STAGE(pb, TL1); bf16* cd = db; const int cl = lb, cg = gb; P0_ISSUE(pb, it + 2 * nworkers, t_hi, db, lb, gb); __syncthreads(); P0_EMIT(TL1, cd, cl, cg); }
        it += nworkers;
    }
    __syncthreads();
}
template <int KR> DI void convert_part(const ConvPtrs& p, LAS float* TL, int tid, int it, int part) {
    const float* srcp; int N; bf16* dst; int ldk, glu; conv_decode(p, it, srcp, N, dst, ldk, glu);
    constexpr int NL = KR / 8;
    f32x4 pa[NL];
#pragma unroll
    for (int i = 0; i < NL; ++i) pa[i] = *(const f32x4*)(srcp + (size_t)(part * KR + (tid >> 6) + 8 * i) * N + (tid & 63) * 4);
#pragma unroll
    for (int i = 0; i < NL; ++i) { const int k = (tid >> 6) + 8 * i; *(LAS f32x4*)(TL + k * 256 + ((((tid & 63) ^ (k >> 3)) & 63) << 2)) = pa[i]; }
    __syncthreads();
    const int c = tid % NL;
#pragma unroll
    for (int q = 0; q < (256 * NL) / 512; ++q) {
        const int n = (tid / NL) + (512 / NL) * q; const int drow = glu ? ((n >> 7) * 256 + (n & 127)) : n;
        const LAS float* s = TL + (8 * c) * 256 + ((((n >> 2) ^ c) & 63) << 2) + (n & 3);
        u32x4 o; o.x = pk2(s[0], s[256]); o.y = pk2(s[2 * 256], s[3 * 256]); o.z = pk2(s[4 * 256], s[5 * 256]); o.w = pk2(s[6 * 256], s[7 * 256]);
        *(u32x4*)(dst + (size_t)drow * ldk + part * KR + 8 * c) = o; }
    __syncthreads();
}
#undef P0_ISSUE
#undef P0_STAGE
#undef P0_EMIT

template <class W> DI void xcd_barrier_work(const XcdBarrier& b, volatile LAS unsigned* flagw, W&& work) {
    asm volatile("s_waitcnt vmcnt(0)" ::: "memory");
    __syncthreads();
    unsigned gen = 0;
    if (threadIdx.x == 0) {
        unsigned* bar = b.bar;
        __builtin_amdgcn_s_waitcnt(0);
        unsigned nloc = b.st[0], nx = b.st[1];
        if (nloc == 0u) { xcd_barrier_complete(bar, b.x, nloc, nx); b.st[0] = nloc; b.st[1] = nx; }
        const unsigned old = xb_add(&bar[XB_XSUB(b.x)], 1u);
        gen = old / nloc;
        if (old + 1u == (gen + 1u) * nloc) {
            __builtin_amdgcn_fence(__ATOMIC_RELEASE, "agent");
            asm volatile("s_waitcnt vmcnt(0)" ::: "memory");
            const unsigned og = xb_add(&bar[XB_TOP], 1u);
            const unsigned tg = og / nx;
            if (og + 1u == (tg + 1u) * nx) xb_add(&bar[XB_TOPGEN], 1u);
            else XB_SPIN(xb_ld(&bar[XB_TOPGEN]) == tg, bar);
            __builtin_amdgcn_fence(__ATOMIC_ACQUIRE, "agent");
            xb_add(&bar[XB_XGEN(b.x)], 1u);
            asm volatile("s_waitcnt vmcnt(0)" ::: "memory");
            flagw[0] = 1u;
        } else if (xb_ld(&bar[XB_XGEN(b.x)]) != gen) { __builtin_amdgcn_fence(__ATOMIC_ACQUIRE, "agent"); asm volatile("s_waitcnt vmcnt(0)" ::: "memory"); flagw[0] = 1u; }
        else flagw[0] = 0u;
    }
    unsigned polls = 0;
    for (;;) {
        __syncthreads();
        const unsigned f = flagw[0];
        if (f) break;
        const bool did = work();
        __syncthreads();
        if (threadIdx.x == 0) {
            unsigned* bar = b.bar; bool rel = xb_ld(&bar[XB_XGEN(b.x)]) != gen;
            if (!rel && !did) { __builtin_amdgcn_s_sleep(1); if ((++polls & 255u) == 0u) { if (xb_ld(&bar[XB_TMO])) rel = true; else if (polls > XB_SPIN_CAP) { atomicAdd(&bar[XB_TMO], 1u); rel = true; } } }
            if (rel) { __builtin_amdgcn_fence(__ATOMIC_ACQUIRE, "agent"); asm volatile("s_waitcnt vmcnt(0)" ::: "memory"); flagw[0] = 1u; }
        }
    }
}

__global__ void __launch_bounds__(NTHREADS, 2) mk_fwd(Args a) {
    extern __shared__ __attribute__((aligned(16))) unsigned char lds[];
    LAS unsigned char* L = (LAS unsigned char*)lds;
    volatile LAS unsigned* MISC = (volatile LAS unsigned*)(L + MISC_OFF);
    const int wave0 = __builtin_amdgcn_readfirstlane(threadIdx.x >> 6);
    const int G = gridDim.x, bid = blockIdx.x;
    if (threadIdx.x < 64) MISC[threadIdx.x] = 0u;
    if (threadIdx.x == 0) {
        LAS unsigned long long* pt = (LAS unsigned long long*)(L + PTAB_OFF);
#pragma unroll
        for (int i = 0; i < 25; ++i) pt[i] = (unsigned long long)a.in[i];
        pt[25] = (unsigned long long)a.out; pt[26] = (unsigned long long)a.ws;
    }
    __syncthreads();
    XcdBarrier bar = xcd_barrier_post((unsigned*)(a.ws + WS_CTL) + CW_BAR, MISC + 8);
#define GRID_BAR() xcd_barrier(bar)
#define CONV_WORK_BODY() \
        const int tidw = wave0 * 64 + lane_id_opaque(); \
        unsigned paw_ = PTAB_OFF; asm volatile("" : "+s"(paw_)); LAS const unsigned long long* PT_ = (LAS const unsigned long long*)(L + paw_); \
        unsigned char* wsw = LDP(unsigned char, 26); \
        const ConvPtrs cpw{nullptr, nullptr, nullptr, nullptr, LDP(const float, 22), LDP(const float, 23), LDP(const float, 24), nullptr, nullptr, nullptr, (bf16*)(wsw + WS_WE1), (bf16*)(wsw + WS_WE2)}; \
        unsigned claimed_ = 0u; \
        auto workfn = [&]() -> bool { \
            if (tidw == 0) MISC[17] = __hip_atomic_fetch_add((unsigned*)(wsw + WS_CTL) + CW_WORK, 1u, __ATOMIC_RELAXED, __HIP_MEMORY_SCOPE_AGENT); \
            __syncthreads(); \
            const unsigned t = MISC[17]; \
            claimed_ = t; \
            if (t >= (unsigned)(NEXP * CONV_TE * (64 / CONV_QK))) return false; \
            const int dt_ = (int)(t / (64 / CONV_QK));                      \
            const int it_ = CONV_T0 + (dt_ < NEXP * 64 ? (dt_ >> 6) * CONV_TE + (dt_ & 63) : ((dt_ - NEXP * 64) >> 5) * CONV_TE + 64 + ((dt_ - NEXP * 64) & 31)); \
            convert_part<CONV_QK>(cpw, (LAS float*)L, tidw, it_, (int)(t % (64 / CONV_QK))); \
            return true; }
#define GRID_BAR_W() do { CONV_WORK_BODY(); xcd_barrier_work(bar, MISC + 16, workfn); } while (0)
#define GRID_BAR_DRAIN(LIM) do { CONV_WORK_BODY(); while (workfn() && claimed_ < (unsigned)(LIM)) { } xcd_barrier(bar); } while (0)
#define LDP(T, i) ((T*)ldp(PT_, (i)))
#define PHASE_IDS() const int lane = lane_id_opaque(), wave = wave0, tid = wave * 64 + lane; (void)lane; (void)wave; (void)tid; \
    unsigned pa_ = PTAB_OFF; asm volatile("" : "+s"(pa_)); LAS const unsigned long long* PT_ = (LAS const unsigned long long*)(L + pa_); \
    [[maybe_unused]] const float* x = LDP(const float, 0); [[maybe_unused]] const float* cvec = LDP(const float, 1); [[maybe_unused]] const float* w_ada = LDP(const float, 2); [[maybe_unused]] const float* b_ada = LDP(const float, 3); \
    [[maybe_unused]] const float* g_pre_mix = LDP(const float, 4); [[maybe_unused]] const float* g_post_mix = LDP(const float, 5); [[maybe_unused]] const float* w_in = LDP(const float, 6); [[maybe_unused]] const float* lb_logits = LDP(const float, 7); \
    [[maybe_unused]] const float* hg_norm_g = LDP(const float, 8); [[maybe_unused]] const float* pool_w = LDP(const float, 9); [[maybe_unused]] const float* pool_scale = LDP(const float, 10); [[maybe_unused]] const float* w_bhg = LDP(const float, 11); \
    [[maybe_unused]] const float* w_bpool = LDP(const float, 12); [[maybe_unused]] const float* w_gate = LDP(const float, 13); [[maybe_unused]] const float* b_gate = LDP(const float, 14); [[maybe_unused]] const float* w_out = LDP(const float, 15); \
    [[maybe_unused]] const float* g_pre_ffn = LDP(const float, 16); [[maybe_unused]] const float* g_post_ffn = LDP(const float, 17); [[maybe_unused]] const float* w_rg = LDP(const float, 18); [[maybe_unused]] const float* b_rg = LDP(const float, 19); \
    [[maybe_unused]] const float* w_re = LDP(const float, 20); [[maybe_unused]] const float* b_re = LDP(const float, 21); [[maybe_unused]] const float* w_eg = LDP(const float, 22); [[maybe_unused]] const float* w_eu = LDP(const float, 23); [[maybe_unused]] const float* w_ed = LDP(const float, 24); \
    [[maybe_unused]] float* out = LDP(float, 25); [[maybe_unused]] unsigned char* ws = LDP(unsigned char, 26); \
    [[maybe_unused]] float* ADAP = (float*)(ws + WS_ADAP); [[maybe_unused]] float* ADA = (float*)(ws + WS_ADA); \
    [[maybe_unused]] int* TOK_E = (int*)(ws + WS_TOK_E); [[maybe_unused]] float* TOK_W = (float*)(ws + WS_TOK_W); [[maybe_unused]] int* TOK_RANK = (int*)(ws + WS_TOK_RANK); [[maybe_unused]] int* TOK_POS = (int*)(ws + WS_TOK_POS); \
    [[maybe_unused]] int* WG_CNT = (int*)(ws + WS_WG_CNT); [[maybe_unused]] int* PSTART = (int*)(ws + WS_PSTART); [[maybe_unused]] int* ROW_TOK = (int*)(ws + WS_ROW_TOK); \
    [[maybe_unused]] bf16* PROJ = (bf16*)(ws + WS_A1); [[maybe_unused]] bf16* MIX = (bf16*)(ws + WS_A1); [[maybe_unused]] bf16* YB = (bf16*)(ws + WS_A1); \
    [[maybe_unused]] bf16* GATE = (bf16*)(ws + WS_A2); [[maybe_unused]] bf16* HMID = (bf16*)(ws + WS_A2); \
    [[maybe_unused]] bf16* HN = (bf16*)(ws + WS_A3); [[maybe_unused]] bf16* MM = (bf16*)(ws + WS_A3); [[maybe_unused]] bf16* HN2 = (bf16*)(ws + WS_A3); \
    [[maybe_unused]] bf16* HP = (bf16*)out; \
    [[maybe_unused]] float* OML = (float*)(ws + WS_OML); \
    [[maybe_unused]] bf16* WT_IN = (bf16*)(ws + WS_WT_IN); [[maybe_unused]] bf16* WT_BR = (bf16*)(ws + WS_WT_BR); [[maybe_unused]] bf16* WT_OUT = (bf16*)(ws + WS_WT_OUT); [[maybe_unused]] bf16* WE1 = (bf16*)(ws + WS_WE1); [[maybe_unused]] bf16* WE2 = (bf16*)(ws + WS_WE2)

    LAS float* Lf = (LAS float*)L;

    for (int rep_ = 0; rep_ < REP_P0; ++rep_) { PHASE_IDS();
    for (int item = bid; item < 24 * 8; item += G) {
        const int chunk = item % 24, ks = item / 24, col = chunk * 256 + (tid & 255), kh = tid >> 8, kb = ks * 128 + kh * 64;
        LAS float* CL = Lf + 1024;
        for (int i = tid; i < 4 * DM; i += NTHREADS) CL[i] = silu(cvec[i]);
        __syncthreads();
        float acc[4] = {0.f, 0.f, 0.f, 0.f};
        for (int k0 = kb; k0 < kb + 64; k0 += 16) {
            float w[16];
#pragma unroll
            for (int j = 0; j < 16; ++j) w[j] = w_ada[(size_t)(k0 + j) * 6144 + col];
            __builtin_amdgcn_sched_barrier(0);
#pragma unroll
            for (int j = 0; j < 16; ++j)
#pragma unroll
                for (int b = 0; b < 4; ++b) acc[b] += CL[b * DM + k0 + j] * w[j];
        }
        if (kh == 1) {
#pragma unroll
            for (int b = 0; b < 4; ++b) Lf[b * 256 + (tid & 255)] = acc[b];
        }
        __syncthreads();
        if (kh == 0) {
#pragma unroll
            for (int b = 0; b < 4; ++b) ADAP[((size_t)ks * 4 + b) * 6144 + col] = acc[b] + Lf[b * 256 + (tid & 255)];
        }
        __syncthreads();
    }
    {
        const ConvPtrs cp{w_in, w_gate, w_bhg, w_out, w_eg, w_eu, w_ed, WT_IN, WT_BR, WT_OUT, WE1, WE2};
        convert_tiles(cp, Lf, tid, 0, CONV_T0, bid, G);
        for (int i = bid * NTHREADS + tid; i < 512; i += G * NTHREADS) OML[i] = 1.0f - 1.0f / (1.0f + __expf(lb_logits[512 + i] - lb_logits[i]));
        for (int blk = G - 1 - bid; blk < 128; blk += G) {
            const int n = (blk & 1) * 512 + tid, cb = blk >> 1, g = cb >> 4;
            LAS float* PWL = Lf;
            __syncthreads();
            for (int i = tid; i < 1024; i += NTHREADS) PWL[i] = pool_w[(size_t)(cb * 8) * 128 + i] * pool_scale[g * 128 + (i & 127)];
            __syncthreads();
            float acc8[8];
#pragma unroll
            for (int j = 0; j < 8; ++j) acc8[j] = 0.f;
            const float* wb = w_bpool + (size_t)(g * 128) * DM + n;
            for (int d0 = 0; d0 < 128; d0 += 16) {
                float w[16];
#pragma unroll
                for (int q = 0; q < 16; ++q) w[q] = wb[(size_t)(d0 + q) * DM];
                __builtin_amdgcn_sched_barrier(0);
#pragma unroll
                for (int q = 0; q < 16; ++q)
#pragma unroll
                    for (int j = 0; j < 8; ++j) acc8[j] += PWL[j * 128 + d0 + q] * w[q];
            }
            u32x4 o; o.x = pk2(acc8[0], acc8[1]); o.y = pk2(acc8[2], acc8[3]); o.z = pk2(acc8[4], acc8[5]); o.w = pk2(acc8[6], acc8[7]);
            *(u32x4*)(WT_BR + (size_t)n * DM + 512 + cb * 8) = o;
        }
    }
    }
    GRID_BAR_W();

    for (int rep_ = 0; rep_ < REP_P1; ++rep_) { PHASE_IDS();
    for (int i = bid * NTHREADS + tid; i < 4 * 6144; i += G * NTHREADS) {
        float s = b_ada[i % 6144];
#pragma unroll
        for (int ks = 0; ks < 8; ++ks) s += ADAP[(size_t)ks * 4 * 6144 + i];
        ADA[i] = s;
    }
    for (int rb = bid; rb < NTOK / 64; rb += G) {
        const int b = rb / 64;
        for (int j = tid; j < 2048; j += NTHREADS) {
            float s = b_ada[j];
#pragma unroll
            for (int ks = 0; ks < 8; ++ks) s += ADAP[((size_t)ks * 4 + b) * 6144 + j];
            Lf[j] = (j >= 1024) ? 1.0f + s : s;
        }
        __syncthreads();
        for (int rr0 = wave * 8; rr0 < wave * 8 + 8; rr0 += 4) {
            f32x4 v[4][4]; float ss[4];
#pragma unroll
            for (int q = 0; q < 4; ++q) { const f32x4* xr = (const f32x4*)(x + (size_t)(rb * 64 + rr0 + q) * DM) + lane; ss[q] = 0.f;
#pragma unroll
                for (int i = 0; i < 4; ++i) v[q][i] = xr[64 * i]; }
#pragma unroll
            for (int q = 0; q < 4; ++q)
#pragma unroll
                for (int i = 0; i < 4; ++i) ss[q] += (v[q][i].x * v[q][i].x + v[q][i].y * v[q][i].y) + (v[q][i].z * v[q][i].z + v[q][i].w * v[q][i].w);
#pragma unroll
            for (int o = 1; o < 64; o <<= 1) {
#pragma unroll
                for (int q = 0; q < 4; ++q) ss[q] += __shfl_xor(ss[q], o); }
#pragma unroll
            for (int q = 0; q < 4; ++q) {
                const float rstd = rsqrtf(ss[q] * (1.0f / DM) + EPS);
                u32x2* o = (u32x2*)(HN + (size_t)(rb * 64 + rr0 + q) * DM) + lane;
#pragma unroll
                for (int i = 0; i < 4; ++i) {
                    const int e = i * 256 + lane * 4;
                    const f32x4 g = *(const f32x4*)(g_pre_mix + e);
                    const float y0 = v[q][i].x * rstd * g.x * Lf[1024 + e] + Lf[e], y1 = v[q][i].y * rstd * g.y * Lf[1024 + e + 1] + Lf[e + 1];
                    const float y2 = v[q][i].z * rstd * g.z * Lf[1024 + e + 2] + Lf[e + 2], y3 = v[q][i].w * rstd * g.w * Lf[1024 + e + 3] + Lf[e + 3];
                    u32x2 w; w.x = pk2(y0, y1); w.y = pk2(y2, y3); o[64 * i] = w;
                }
            }
        }
        __syncthreads();
    }
    }
    GRID_BAR_W();

    for (int rep_ = 0; rep_ < REP_P2; ++rep_) { PHASE_IDS();
    { pg8::DenseSched S; S.init(HN, WT_IN, NTOK, NPG, DM, G, bid); pg8::EpiProj E{PROJ, GATE, OML, b_gate}; pg8::gemm_phase<1024>(L, S, E, wave0); }
    }
    GRID_BAR_W();

    for (int rep_ = 0; rep_ < REP_P3; ++rep_) { PHASE_IDS();
        typedef short bf16x8 __attribute__((ext_vector_type(8)));
        const int sub = wave >> 2, st = tid & 255, w4 = wave & 3, fr = lane & 15, fq = lane >> 4;
        LAS unsigned char* KT = L + sub * 36864; LAS unsigned char* VT = KT + 18432;
        bf16* ST = (bf16*)(ws + WS_A3); float* DEC = (float*)(ws + WS_DEC); float* DECM = DEC + 1024 * 128;
        for (int u0 = bid * 2; u0 < NB * NHEAD * NCHUNK; u0 += G * 2) {
            const int u = u0 + sub, bh = u >> 6, c = u & 63, b = bh >> 2, h = bh & 3;
            const size_t row0 = (size_t)b * SEQ + (size_t)c * CHUNK;
            {
                const int k = st & 127, hf = st >> 7;
                const bf16* src = PROJ + row0 * PROJW + 512 + h * HD + k; const bf16* vp = src + 512 + (size_t)(hf * 32) * PROJW;
                unsigned kr[32], k2[32], vr[32];
#pragma unroll
                for (int s = 0; s < 32; ++s) { kr[s] = src[(size_t)(hf * 32 + s) * PROJW]; vr[s] = vp[(size_t)s * PROJW]; k2[s] = src[(size_t)(32 + s) * PROJW]; }
                __builtin_amdgcn_sched_barrier(0);
                float t2 = 0.f;
                if (hf == 0) {
#pragma unroll
                    for (int s = 0; s < 32; ++s) t2 += __logf(1.0f - __uint_as_float(k2[s] << 16));
                }
                float suf = t2;
#pragma unroll
                for (int g8 = 3; g8 >= 0; --g8) {
                    float kh[8];
#pragma unroll
                    for (int j = 7; j >= 0; --j) { const float kk = __uint_as_float(kr[g8 * 8 + j] << 16); kh[j] = kk * __expf(suf); suf += __logf(1.0f - kk); }
                    u32x4 w; w.x = pk2(kh[0], kh[1]); w.y = pk2(kh[2], kh[3]); w.z = pk2(kh[4], kh[5]); w.w = pk2(kh[6], kh[7]);
                    *(LAS u32x4*)(KT + k * 144 + (hf * 32 + g8 * 8) * 2) = w;
                }
                if (hf == 0) { DEC[u * 128 + k] = __expf(suf); DECM[u * 128 + k] = __expf(suf - t2); }
#pragma unroll
                for (int g8 = 0; g8 < 4; ++g8) {
                    u32x4 w; w.x = vr[g8 * 8] | (vr[g8 * 8 + 1] << 16); w.y = vr[g8 * 8 + 2] | (vr[g8 * 8 + 3] << 16); w.z = vr[g8 * 8 + 4] | (vr[g8 * 8 + 5] << 16); w.w = vr[g8 * 8 + 6] | (vr[g8 * 8 + 7] << 16);
                    *(LAS u32x4*)(VT + k * 144 + (hf * 32 + g8 * 8) * 2) = w;
                }
            }
            __syncthreads();
            f32x4 acc[2][8];
#pragma unroll
            for (int i = 0; i < 2; ++i)
#pragma unroll
                for (int vb = 0; vb < 8; ++vb) acc[i][vb] = (f32x4){0.f, 0.f, 0.f, 0.f};
#pragma unroll
            for (int ks = 0; ks < 2; ++ks) {
                bf16x8 af[2];
#pragma unroll
                for (int i = 0; i < 2; ++i) af[i] = *(const LAS bf16x8*)(KT + (16 * (2 * w4 + i) + fr) * 144 + (32 * ks + 8 * fq) * 2);
#pragma unroll
                for (int vb = 0; vb < 8; ++vb) { const bf16x8 bfv = *(const LAS bf16x8*)(VT + (16 * vb + fr) * 144 + (32 * ks + 8 * fq) * 2);
#pragma unroll
                    for (int i = 0; i < 2; ++i) acc[i][vb] = __builtin_amdgcn_mfma_f32_16x16x32_bf16(af[i], bfv, acc[i][vb], 0, 0, 0); }
            }
#pragma unroll
            for (int i = 0; i < 2; ++i)
#pragma unroll
                for (int vb = 0; vb < 8; ++vb) { u32x2 w; w.x = pk2(acc[i][vb][0], acc[i][vb][1]); w.y = pk2(acc[i][vb][2], acc[i][vb][3]);
                    *(u32x2*)(ST + (size_t)u * 16384 + ((vb * 4 + w4) * 64 + ((2 * i + (fq >> 1)) * 16 + fr)) * 8 + 4 * (fq & 1)) = w; }
            __syncthreads();
        }
        for (int run = bid * NWAVES + wave; run < NTOK / 8; run += G * NWAVES) {
            const int m0 = run * 8, t0 = m0 & (SEQ - 1), w = 2 << (lane >> 4);
            u32x4 rows[23];
#pragma unroll
            for (int j = 0; j < 23; ++j) { const int t = t0 - 15 + j; rows[j] = (t >= 0) ? *(const u32x4*)(PROJ + (size_t)(m0 - 15 + j) * PROJW + 2048 + lane * 8) : (u32x4){0u, 0u, 0u, 0u}; }
#define ROWV(j, q) (((q) & 1) ? hi_bf(((q) >> 1) == 0 ? rows[j].x : (((q) >> 1) == 1 ? rows[j].y : (((q) >> 1) == 2 ? rows[j].z : rows[j].w))) : lo_bf(((q) >> 1) == 0 ? rows[j].x : (((q) >> 1) == 1 ? rows[j].y : (((q) >> 1) == 2 ? rows[j].z : rows[j].w))))
            float S[8];
#pragma unroll
            for (int q = 0; q < 8; ++q) S[q] = 0.f;
#pragma unroll
            for (int j = 0; j < 15; ++j) { const bool in = (15 - j) < w;
#pragma unroll
                for (int q = 0; q < 8; ++q) S[q] += in ? ROWV(j, q) : 0.f; }
#pragma unroll
            for (int s = 0; s < 8; ++s) {
                const int j = 15 + s, t = t0 + s; const int cnt = (t + 1 < w) ? t + 1 : w; const float inv = 1.0f / (float)cnt;
                float y[8];
#pragma unroll
                for (int q = 0; q < 8; ++q) {
                    const float u = ROWV(j, q); S[q] += u; y[q] = S[q] * inv - u;
                    const float r1 = ROWV(j - 1, q), r3 = ROWV(j - 3, q), r7 = ROWV(j - 7, q), r15 = ROWV(j - 15, q);
                    S[q] -= (w == 2) ? r1 : ((w == 4) ? r3 : ((w == 8) ? r7 : r15));
                }
                u32x4 o; o.x = pk2(y[0], y[1]); o.y = pk2(y[2], y[3]); o.z = pk2(y[4], y[5]); o.w = pk2(y[6], y[7]);
                *(u32x4*)(HP + (size_t)(m0 + s) * DM + 512 + lane * 8) = o;
            }
#undef ROWV
        }
    }
    GRID_BAR_W();

    for (int rep_ = 0; rep_ < REP_P4; ++rep_) { PHASE_IDS();
        bf16* ST = (bf16*)(ws + WS_A3); const float* DEC = (const float*)(ws + WS_DEC); const float* DECM = DEC + 1024 * 128;
        typedef float f32x2 __attribute__((ext_vector_type(2)));
        for (int g = bid * NTHREADS + tid; g < NB * NHEAD * 128 * 64; g += G * NTHREADS) {
            const int p = 2 * (g & 8191), bh = g >> 13, k = 32 * ((p >> 9) & 3) + 8 * ((p >> 7) & 3) + (p & 7);
            unsigned* stp = (unsigned*)(ST + (size_t)bh * 64 * 16384 + p);
            const float* dp = DEC + (size_t)bh * 64 * 128 + k; const float* mp = DECM + (size_t)bh * 64 * 128 + k;
            float s0 = 0.f, s1 = 0.f;
            for (int c0 = 0; c0 < NCHUNK; c0 += 8) {
                unsigned kv[8]; f32x2 d[8], m[8];
#pragma unroll
                for (int j = 0; j < 8; ++j) { kv[j] = stp[(size_t)(c0 + j) * 8192]; d[j] = *(const f32x2*)(dp + (c0 + j) * 128); m[j] = *(const f32x2*)(mp + (c0 + j) * 128); }
#pragma unroll
                for (int j = 0; j < 8; ++j) { stp[(size_t)(c0 + j) * 8192] = pk2(s0 * m[j].x, s1 * m[j].y); s0 = d[j].x * s0 + lo_bf(kv[j]); s1 = d[j].y * s1 + hi_bf(kv[j]); }
            }
        }
    }
    GRID_BAR_W();

    for (int rep_ = 0; rep_ < REP_P5; ++rep_) { PHASE_IDS();
        typedef short bf16x8 __attribute__((ext_vector_type(8)));
        typedef short s16x4 __attribute__((ext_vector_type(4)));
        const int sub = wave >> 2, st = tid & 255, w4 = wave & 3, fr = lane & 15, fq = lane >> 4;
        LAS unsigned char* QS = L + sub * 53248; LAS unsigned char* KS = QS + 17408; LAS unsigned char* VT = KS + 17408;
        const bf16* ST = (const bf16*)(ws + WS_A3);
        for (int u0 = bid * 2; u0 < NB * NHEAD * NCHUNK; u0 += G * 2) {
            const int u = u0 + sub, bh = u >> 6, c = u & 63, b = bh >> 2, h = bh & 3;
            const size_t row0 = (size_t)b * SEQ + (size_t)c * CHUNK;
            {
                const int k = st & 127, hf = st >> 7;
                const bf16* kp = PROJ + (row0 + hf * 32) * PROJW + 512 + h * HD + k; const bf16* qp = kp - 512; const bf16* vp = kp + 512;
                unsigned kr[32], qr[32], vr[32];
#pragma unroll
                for (int s = 0; s < 32; ++s) { kr[s] = kp[(size_t)s * PROJW]; qr[s] = qp[(size_t)s * PROJW]; vr[s] = vp[(size_t)s * PROJW]; }
                __builtin_amdgcn_sched_barrier(0);
                if (hf == 1) {
                    float cs = 0.f;
#pragma unroll
                    for (int s = 0; s < 32; ++s) { const float kk = __uint_as_float(kr[s] << 16), q = __uint_as_float(qr[s] << 16); cs += __logf(1.0f - kk);
                        *(LAS bf16*)(QS + (32 + s) * 272 + k * 2) = (bf16)f2bf(q * __expf(cs)); *(LAS bf16*)(KS + (32 + s) * 272 + k * 2) = (bf16)f2bf(kk * __expf(-cs)); }
                } else {
                    float d = 0.f;
#pragma unroll
                    for (int s = 31; s >= 0; --s) { const float kk = __uint_as_float(kr[s] << 16), q = __uint_as_float(qr[s] << 16);
                        *(LAS bf16*)(QS + s * 272 + k * 2) = (bf16)f2bf(q * __expf(-d)); *(LAS bf16*)(KS + s * 272 + k * 2) = (bf16)f2bf(kk * __expf(d)); d += __logf(1.0f - kk); }
                }
#pragma unroll
                for (int g8 = 0; g8 < 4; ++g8) {
                    u32x4 w; w.x = vr[g8 * 8] | (vr[g8 * 8 + 1] << 16); w.y = vr[g8 * 8 + 2] | (vr[g8 * 8 + 3] << 16); w.z = vr[g8 * 8 + 4] | (vr[g8 * 8 + 5] << 16); w.w = vr[g8 * 8 + 6] | (vr[g8 * 8 + 7] << 16);
                    *(LAS u32x4*)(VT + k * 144 + (hf * 32 + g8 * 8) * 2) = w;
                }
            }
            __syncthreads();
            const int tb = w4;
            bf16x8 sf[4][8];
#pragma unroll
            for (int vb = 0; vb < 8; ++vb) { const bf16* bp = ST + (size_t)u * 16384 + (size_t)lane * 8 + vb * 2048;
#pragma unroll
                for (int ks = 0; ks < 4; ++ks) sf[ks][vb] = *(const bf16x8*)(bp + ks * 512); }
            __builtin_amdgcn_sched_barrier(0);
            bf16x8 qf[4];
#pragma unroll
            for (int ks = 0; ks < 4; ++ks) qf[ks] = *(const LAS bf16x8*)(QS + (16 * tb + fr) * 272 + (32 * ks + 8 * fq) * 2);
            f32x4 sc[4];
#pragma unroll
            for (int sb = 0; sb < 4; ++sb) {
                sc[sb] = (f32x4){0.f, 0.f, 0.f, 0.f};
                if (sb <= tb) {
#pragma unroll
                    for (int ks = 0; ks < 4; ++ks) { const bf16x8 kf = *(const LAS bf16x8*)(KS + (16 * sb + fr) * 272 + (32 * ks + 8 * fq) * 2); sc[sb] = __builtin_amdgcn_mfma_f32_16x16x32_bf16(kf, qf[ks], sc[sb], 0, 0, 0); }
                    if (sb == tb) {
#pragma unroll
                        for (int r = 0; r < 4; ++r) if (4 * fq + r > fr) sc[sb][r] = 0.f;
                    }
                }
            }
            f32x4 o[8];
#pragma unroll
            for (int vb = 0; vb < 8; ++vb) o[vb] = (f32x4){0.f, 0.f, 0.f, 0.f};
#pragma unroll
            for (int p = 0; p < 2; ++p) {
                if (2 * p <= tb) {
                    u32x4 pw; pw.x = pk2(sc[2 * p][0], sc[2 * p][1]); pw.y = pk2(sc[2 * p][2], sc[2 * p][3]); pw.z = pk2(sc[2 * p + 1][0], sc[2 * p + 1][1]); pw.w = pk2(sc[2 * p + 1][2], sc[2 * p + 1][3]);
                    const bf16x8 pf = __builtin_bit_cast(bf16x8, pw);
#pragma unroll
                    for (int vb = 0; vb < 8; ++vb) {
                        const s16x4 lo = *(const LAS s16x4*)(VT + (16 * vb + fr) * 144 + (32 * p + 4 * fq) * 2), hi = *(const LAS s16x4*)(VT + (16 * vb + fr) * 144 + (32 * p + 16 + 4 * fq) * 2);
                        const bf16x8 vf = __builtin_shufflevector(lo, hi, 0, 1, 2, 3, 4, 5, 6, 7);
                        o[vb] = __builtin_amdgcn_mfma_f32_16x16x32_bf16(vf, pf, o[vb], 0, 0, 0);
                    }
                }
            }
#pragma unroll
            for (int ks = 0; ks < 4; ++ks)
#pragma unroll
                for (int vb = 0; vb < 8; ++vb) o[vb] = __builtin_amdgcn_mfma_f32_16x16x32_bf16(sf[ks][vb], qf[ks], o[vb], 0, 0, 0);
            float ss = 0.f;
#pragma unroll
            for (int vb = 0; vb < 8; ++vb) ss += (o[vb][0] * o[vb][0] + o[vb][1] * o[vb][1]) + (o[vb][2] * o[vb][2] + o[vb][3] * o[vb][3]);
            ss += __shfl_xor(ss, 16); ss += __shfl_xor(ss, 32);
            const float rstd = rsqrtf(ss * (1.0f / HD) + EPS);
            const size_t row = row0 + 16 * tb + fr;
            u32x2 gwv[8]; f32x4 ngv[8];
#pragma unroll
            for (int vb = 0; vb < 8; ++vb) { const int col = h * HD + 16 * vb + 4 * fq; gwv[vb] = *(const u32x2*)(PROJ + row * PROJW + 1536 + col); ngv[vb] = *(const f32x4*)(hg_norm_g + col); }
            __builtin_amdgcn_sched_barrier(0);
#pragma unroll
            for (int vb = 0; vb < 8; ++vb) {
                const int col = h * HD + 16 * vb + 4 * fq;
                const u32x2 gw = gwv[vb]; const f32x4 ng = ngv[vb];
                u32x2 w; w.x = pk2(o[vb][0] * rstd * ng.x * lo_bf(gw.x), o[vb][1] * rstd * ng.y * hi_bf(gw.x)); w.y = pk2(o[vb][2] * rstd * ng.z * lo_bf(gw.y), o[vb][3] * rstd * ng.w * hi_bf(gw.y));
                *(u32x2*)(HP + row * DM + col) = w;
            }
            __syncthreads();
        }
    }
    GRID_BAR_W();

    for (int rep_ = 0; rep_ < REP_P6; ++rep_) { PHASE_IDS();
    { pg8::DenseSched S; S.init(HP, WT_BR, NTOK, DM, DM, G, bid); pg8::EpiMix E{MM, GATE}; pg8::gemm_phase<1024>(L, S, E, wave0); }
    }
    GRID_BAR_W();

    for (int rep_ = 0; rep_ < REP_P7; ++rep_) { PHASE_IDS();
    { pg8::DenseSched S; S.init(MM, WT_OUT, NTOK, DM, DM, G, bid); pg8::EpiPlain E{MIX, DM}; pg8::gemm_phase<1024>(L, S, E, wave0); }
    }
    GRID_BAR_W();

    for (int rep_ = 0; rep_ < REP_P8; ++rep_) { PHASE_IDS();
        typedef short bf16x8 __attribute__((ext_vector_type(8)));
        const int fr = lane & 15, fq = lane >> 4;
        LAS unsigned char* HTH = L; LAS unsigned char* HTL = L + 33024;
        LAS float* PL = (LAS float*)(L + 66048);
        LAS float* LGT = (LAS float*)(L + 90624);
        LAS int* LE = (LAS int*)(L + 93184); LAS int* LR = LE + 128;
        bf16x8 wh[4][3], wl[4][3];
#pragma unroll
        for (int ks = 0; ks < 4; ++ks)
#pragma unroll
            for (int ct = 0; ct < 3; ++ct) {
                const int j = 16 * ct + fr; u32x4 hw, lw; unsigned hh[4], ll[4];
#pragma unroll
                for (int p = 0; p < 4; ++p) {
                    const int k = 128 * wave + 32 * ks + 8 * fq + 2 * p;
                    const float w0 = (j < 4) ? w_rg[k * 4 + j] : ((j < 36) ? w_re[k * 32 + j - 4] : 0.f), w1 = (j < 4) ? w_rg[(k + 1) * 4 + j] : ((j < 36) ? w_re[(k + 1) * 32 + j - 4] : 0.f);
                    const unsigned h0 = f2bf(w0), h1 = f2bf(w1); const unsigned l0 = f2bf(w0 - __uint_as_float(h0 << 16)), l1 = f2bf(w1 - __uint_as_float(h1 << 16));
                    hh[p] = h0 | (h1 << 16); ll[p] = l0 | (l1 << 16);
                }
                hw.x = hh[0]; hw.y = hh[1]; hw.z = hh[2]; hw.w = hh[3]; lw.x = ll[0]; lw.y = ll[1]; lw.z = ll[2]; lw.w = ll[3];
                wh[ks][ct] = __builtin_bit_cast(bf16x8, hw); wl[ks][ct] = __builtin_bit_cast(bf16x8, lw);
            }
        for (int rb = bid; rb < NTOK / 64; rb += G) {
            const int b = rb / 64; const float* ada = ADA + (size_t)b * 6144;
            f32x4 A1[4], A2[4], SH[4];
#pragma unroll
            for (int i = 0; i < 4; ++i) { const int e = i * 256 + lane * 4;
                A1[i] = *(const f32x4*)(g_post_mix + e) * *(const f32x4*)(ada + 2048 + e);
                A2[i] = *(const f32x4*)(g_pre_ffn + e) * (*(const f32x4*)(ada + 4096 + e) + 1.0f);
                SH[i] = *(const f32x4*)(ada + 3072 + e); }
            for (int grp = 0; grp < 4; ++grp) {
                f32x4 xin[2][4]; u32x2 min_[2][4];
#pragma unroll
                for (int i2 = 0; i2 < 2; ++i2) { const int r = rb * 64 + grp * 16 + 2 * wave + i2;
                    const f32x4* xr = (const f32x4*)(x + (size_t)r * DM) + lane; const u32x2* mr = (const u32x2*)(MIX + (size_t)r * DM) + lane;
#pragma unroll
                    for (int i = 0; i < 4; ++i) { xin[i2][i] = xr[64 * i]; min_[i2][i] = mr[64 * i]; } }
                __builtin_amdgcn_sched_barrier(0);
#pragma unroll
                for (int i2 = 0; i2 < 2; ++i2) {
                    const int rl = 2 * wave + i2, r = rb * 64 + grp * 16 + rl;
                    f32x4 hv[4], mx[4]; float ss = 0.f;
#pragma unroll
                    for (int i = 0; i < 4; ++i) { const u32x2 w = min_[i2][i]; mx[i] = (f32x4){lo_bf(w.x), hi_bf(w.x), lo_bf(w.y), hi_bf(w.y)}; hv[i] = xin[i2][i];
                        ss += (mx[i].x * mx[i].x + mx[i].y * mx[i].y) + (mx[i].z * mx[i].z + mx[i].w * mx[i].w); }
                    const float rstd1 = rsqrtf(wave_sum(ss) * (1.0f / DM) + EPS);
                    float s2 = 0.f;
#pragma unroll
                    for (int i = 0; i < 4; ++i) { const f32x4 h = hv[i] + A1[i] * (mx[i] * rstd1); hv[i] = h; s2 += (h.x * h.x + h.y * h.y) + (h.z * h.z + h.w * h.w);
                        *((f32x4*)(out + (size_t)r * DM) + lane + 64 * i) = h; }
                    const float rstd2 = rsqrtf(wave_sum(s2) * (1.0f / DM) + EPS);
                    u32x2* o = (u32x2*)(HN2 + (size_t)r * DM) + lane;
#pragma unroll
                    for (int i = 0; i < 4; ++i) { const f32x4 y = hv[i] * rstd2 * A2[i] + SH[i];
                        const unsigned h0 = f2bf(y.x), h1 = f2bf(y.y), h2 = f2bf(y.z), h3 = f2bf(y.w);
                        u32x2 wv; wv.x = h0 | (h1 << 16); wv.y = h2 | (h3 << 16); o[64 * i] = wv;
                        u32x2 lv; lv.x = pk2(y.x - __uint_as_float(h0 << 16), y.y - __uint_as_float(h1 << 16)); lv.y = pk2(y.z - __uint_as_float(h2 << 16), y.w - __uint_as_float(h3 << 16));
                        *(LAS u32x2*)(HTH + rl * 2064 + (i * 256 + lane * 4) * 2) = wv; *(LAS u32x2*)(HTL + rl * 2064 + (i * 256 + lane * 4) * 2) = lv; }
                }
                __syncthreads();
                f32x4 acc[3];
#pragma unroll
                for (int ct = 0; ct < 3; ++ct) acc[ct] = (f32x4){0.f, 0.f, 0.f, 0.f};
#pragma unroll
                for (int ks = 0; ks < 4; ++ks) {
                    const bf16x8 ah = *(const LAS bf16x8*)(HTH + fr * 2064 + (128 * wave + 32 * ks + 8 * fq) * 2), al = *(const LAS bf16x8*)(HTL + fr * 2064 + (128 * wave + 32 * ks + 8 * fq) * 2);
#pragma unroll
                    for (int ct = 0; ct < 3; ++ct) {
                        acc[ct] = __builtin_amdgcn_mfma_f32_16x16x32_bf16(ah, wh[ks][ct], acc[ct], 0, 0, 0);
                        acc[ct] = __builtin_amdgcn_mfma_f32_16x16x32_bf16(ah, wl[ks][ct], acc[ct], 0, 0, 0);
                        acc[ct] = __builtin_amdgcn_mfma_f32_16x16x32_bf16(al, wh[ks][ct], acc[ct], 0, 0, 0);
                    }
                }
#pragma unroll
                for (int ct = 0; ct < 3; ++ct)
#pragma unroll
                    for (int q = 0; q < 4; ++q) PL[(wave * 16 + 4 * fq + q) * 48 + 16 * ct + fr] = acc[ct][q];
                __syncthreads();
                for (int idx = tid; idx < 16 * 36; idx += NTHREADS) { const int row = idx / 36, col = idx % 36; float s = (col < 4) ? b_rg[col] : b_re[col - 4];
#pragma unroll
                    for (int w8 = 0; w8 < 8; ++w8) s += PL[(w8 * 16 + row) * 48 + col];
                    LGT[row * 40 + col] = s; }
                __syncthreads();
                if (tid < 16) {
                    const int rl = tid, r = rb * 64 + grp * 16 + rl; const LAS float* lg = LGT + rl * 40;
                    int gi = 0; float gm = lg[0];
#pragma unroll
                    for (int j = 1; j < 4; ++j) if (lg[j] > gm) { gm = lg[j]; gi = j; }
                    float den = 0.f;
#pragma unroll
                    for (int j = 0; j < 4; ++j) den += __expf(lg[j] - gm);
                    const float ptg = 1.0f / den;
                    int e1 = 0, e2 = 0; float l1 = -3.0e38f, l2 = -3.0e38f;
                    for (int j = 0; j < 8; ++j) { const float l = lg[4 + gi * 8 + j];
                        if (l > l1) { l2 = l1; e2 = e1; l1 = l; e1 = j; } else if (l > l2) { l2 = l; e2 = j; } }
                    const float w1 = 1.0f / (1.0f + __expf(l2 - l1));
                    TOK_E[r * 2] = gi * 8 + e1; TOK_E[r * 2 + 1] = gi * 8 + e2;
                    TOK_W[r * 2] = ptg * w1; TOK_W[r * 2 + 1] = ptg * (1.0f - w1);
                    LE[(grp * 16 + rl) * 2] = gi * 8 + e1; LE[(grp * 16 + rl) * 2 + 1] = gi * 8 + e2;
                }
            }
            __syncthreads();
            if (tid < NEXP) { int cnt = 0; for (int i = 0; i < 128; ++i) if (LE[i] == tid) { LR[i] = cnt; ++cnt; } WG_CNT[rb * NEXP + tid] = cnt; }
            __syncthreads();
            if (tid < 128) TOK_RANK[rb * 128 + tid] = LR[tid];
            __syncthreads();
        }
    }
    GRID_BAR_W();

    for (int rep_ = 0; rep_ < REP_P9; ++rep_) { PHASE_IDS();
    {
        LAS int* CN = (LAS int*)Lf;
        LAS int* PS = CN + 8192;
        LAS int* TOT = PS + 64;
        LAS int* PRE = PS + 128;
        for (int i = tid; i < (NTOK / 64) * NEXP; i += NTHREADS) CN[i] = WG_CNT[i];
        __syncthreads();
        for (int rb = bid; rb < NTOK / 64; rb += G) {
            if (tid < NEXP) { int run = 0, pre = 0;
#pragma unroll 8
                for (int q = 0; q < NTOK / 64; ++q) { if (q == rb) pre = run; run += CN[q * NEXP + tid]; } TOT[tid] = run; PRE[tid] = pre; }
            __syncthreads();
            if (tid == 0) { int s = 0; for (int e = 0; e < NEXP; ++e) { PS[e] = s; s += ((TOT[e] + 255) / 256) * 256; } PS[NEXP] = s; }
            __syncthreads();
            if (tid < 128) { const int aidx = rb * 128 + tid, e = TOK_E[aidx], pos = PS[e] + PRE[e] + TOK_RANK[aidx]; TOK_POS[aidx] = pos; ROW_TOK[pos] = aidx >> 1; }
            if (rb < NEXP) { const int e = rb; for (int p = PS[e] + TOT[e] + tid; p < PS[e + 1]; p += NTHREADS) ROW_TOK[p] = 0; }
            if (rb == 0 && tid <= NEXP) PSTART[tid] = PS[tid];
            __syncthreads();
        }
    }
    }
    GRID_BAR_DRAIN(NEXP * 64 * (64 / CONV_QK));

    for (int rep_ = 0; rep_ < REP_P10; ++rep_) { PHASE_IDS();
    { pg8::MoeSched<true> S; S.init(HN2, WE1, PSTART, ROW_TOK, 4, 1024, DM, G, bid, (LAS int*)(L + UT_OFF), tid); pg8::EpiGlu E{HMID}; pg8::gemm_phase<1024>(L, S, E, wave0); }
    }
    GRID_BAR_DRAIN(NEXP * CONV_TE * (64 / CONV_QK));

    for (int rep_ = 0; rep_ < REP_P11; ++rep_) { PHASE_IDS();
    { pg8::MoeSched<false> S; S.init(HMID, WE2, PSTART, ROW_TOK, 4, 1024, EFF, G, bid, (LAS int*)(L + UT_OFF), tid); pg8::EpiPlain E{YB, DM}; pg8::gemm_phase<512>(L, S, E, wave0); }
    }
    GRID_BAR();

    for (int rep_ = 0; rep_ < REP_P12; ++rep_) { PHASE_IDS();
    for (int r0 = (bid * NWAVES + wave) * 4; r0 < NTOK; r0 += G * NWAVES * 4) {
        const int b = r0 / SEQ; const float* ada = ADA + (size_t)b * 6144;
        int pp[4][2]; float ww[4][2];
#pragma unroll
        for (int q = 0; q < 4; ++q) { pp[q][0] = TOK_POS[(r0 + q) * 2]; pp[q][1] = TOK_POS[(r0 + q) * 2 + 1]; ww[q][0] = TOK_W[(r0 + q) * 2]; ww[q][1] = TOK_W[(r0 + q) * 2 + 1]; }
        u32x2 ya[4][2][4]; f32x4 hin[4][4];
#pragma unroll
        for (int q = 0; q < 4; ++q) {
#pragma unroll
            for (int kk = 0; kk < 2; ++kk) { const u32x2* yp = (const u32x2*)(YB + (size_t)pp[q][kk] * DM) + lane;
#pragma unroll
                for (int i = 0; i < 4; ++i) ya[q][kk][i] = yp[64 * i]; }
#pragma unroll
            for (int i = 0; i < 4; ++i) hin[q][i] = *((const f32x4*)(out + (size_t)(r0 + q) * DM) + lane + 64 * i);
        }
        f32x4 gpf[4], gt2[4];
#pragma unroll
        for (int i = 0; i < 4; ++i) { const int e = i * 256 + lane * 4; gpf[i] = *(const f32x4*)(g_post_ffn + e); gt2[i] = *(const f32x4*)(ada + 5120 + e); }
        __builtin_amdgcn_sched_barrier(0);
#pragma unroll
        for (int q = 0; q < 4; ++q) {
            const float w0 = ww[q][0], w1 = ww[q][1];
            f32x4 yv[4]; float ss = 0.f;
#pragma unroll
            for (int i = 0; i < 4; ++i) { const u32x2 a0 = ya[q][0][i], a1 = ya[q][1][i];
                f32x4 y; y.x = w0 * lo_bf(a0.x) + w1 * lo_bf(a1.x); y.y = w0 * hi_bf(a0.x) + w1 * hi_bf(a1.x); y.z = w0 * lo_bf(a0.y) + w1 * lo_bf(a1.y); y.w = w0 * hi_bf(a0.y) + w1 * hi_bf(a1.y);
                yv[i] = y; ss += (y.x * y.x + y.y * y.y) + (y.z * y.z + y.w * y.w); }
            const float rstd = rsqrtf(wave_sum(ss) * (1.0f / DM) + EPS);
#pragma unroll
            for (int i = 0; i < 4; ++i) *((f32x4*)(out + (size_t)(r0 + q) * DM) + lane + 64 * i) = hin[q][i] + gt2[i] * (yv[i] * rstd * gpf[i]);
        }
    }
    }
}

extern "C" void kernel_launch(void* const* d_in, const int* in_sizes, int n_in, void* d_out, int out_size, void* d_ws, size_t ws_size, hipStream_t stream) {
    static int grid = 0;
    if (grid == 0) {
        int dev = 0, cus = 0, per_cu = 0;
        if (n_in != 25 || out_size != NTOK * DM || ws_size < WS_END) { fprintf(stderr, "kernel_launch: unexpected problem (n_in %d out %d ws %zu)\n", n_in, out_size, ws_size); grid = -1; return; }
        if (hipGetDevice(&dev) != hipSuccess || hipDeviceGetAttribute(&cus, hipDeviceAttributeMultiprocessorCount, dev) != hipSuccess) { grid = -1; return; }
        if (hipFuncSetAttribute((const void*)mk_fwd, hipFuncAttributeMaxDynamicSharedMemorySize, LDS_BYTES) != hipSuccess) { fprintf(stderr, "hipFuncSetAttribute failed\n"); grid = -1; return; }
        if (hipOccupancyMaxActiveBlocksPerMultiprocessor(&per_cu, (const void*)mk_fwd, NTHREADS, LDS_BYTES) != hipSuccess || per_cu < 1) { fprintf(stderr, "occupancy query: %d\n", per_cu); }
        (void)hipGetLastError();
        grid = cus;
    }
    if (grid < 0) return;
    (void)hipMemsetAsync((char*)d_ws + WS_CTL, 0, CTL_BYTES, stream);
    Args a{};
    for (int i = 0; i < 25; ++i) a.in[i] = (const float*)d_in[i];
    a.out = (float*)d_out; a.ws = (unsigned char*)d_ws; a.ph_lo = 0; a.ph_hi = 100;
    hipLaunchKernelGGL(mk_fwd, dim3(grid), dim3(NTHREADS), LDS_BYTES, stream, a);
}
```
